# Optimizing an MI355X kernel written in HIP

```python
import math
import jax, jax.numpy as jnp
from jax import lax
import numpy as np

D_MODEL = 2048
BATCH = 4
SEQ = 4096
DEPTH = 1

HEAD_DIM = 128
N_HEADS_TOTAL = D_MODEL // HEAD_DIM
N_DIFF_HEADS = N_HEADS_TOTAL // 2
N_MOBA_HEADS = N_HEADS_TOTAL - N_DIFF_HEADS
DIFF_SUB = HEAD_DIM // 2
DIFF_W = N_DIFF_HEADS * HEAD_DIM
MOBA_W = N_MOBA_HEADS * HEAD_DIM
MIX_W = DIFF_W + MOBA_W
IN_COLS = 3 * DIFF_W + 3 * MOBA_W
ROPE_THETA = 500000.0
ROT_FRACTION = 4
MOBA_BLOCK = 256
MOBA_TOPK = 3
MOBA_Q_CHUNK = 32
DIFF_Q_CHUNK = 128
FFN_DIM = 5632
CONV_W = 3
LN_EPS = 1e-5
RMS_EPS = 1e-5
DEEPNORM_ALPHA = (2.0 * DEPTH) ** 0.25
DEEPNORM_BETA = (8.0 * DEPTH) ** -0.25
DIFF_SCALE = DIFF_SUB ** -0.5
MOBA_SCALE = HEAD_DIM ** -0.5

kernel_name = "hymba_diffattn_moba_convffn_deepnorm"


def rope_tables(seq, rot_dim):
    inv = 1.0 / (ROPE_THETA ** (jnp.arange(0, rot_dim, 2, dtype=jnp.float32) / rot_dim))
    pos = jnp.arange(seq, dtype=jnp.float32)
    ang = pos[:, None] * inv[None, :]
    return jnp.cos(ang), jnp.sin(ang)


def apply_partial_rope(x, cos, sin):
    half = cos.shape[-1]
    rot = 2 * half
    x1, x2, xp = x[..., :half], x[..., half:rot], x[..., rot:]
    c = cos.astype(x.dtype)
    s = sin.astype(x.dtype)
    return jnp.concatenate([x1 * c - x2 * s, x2 * c + x1 * s, xp], axis=-1)


def layer_norm(x, g, b):
    xf = x.astype(jnp.float32)
    mu = jnp.mean(xf, axis=-1, keepdims=True)
    var = jnp.mean(jnp.square(xf - mu), axis=-1, keepdims=True)
    y = (xf - mu) * lax.rsqrt(var + LN_EPS)
    return (y * g.astype(jnp.float32) + b.astype(jnp.float32)).astype(x.dtype)


def diff_attention(q, k, v, lam, lam_init, subln_g, cos, sin):
    B, S = q.shape[0], q.shape[1]
    H = N_DIFF_HEADS
    q = q.reshape(B, S, H, 2, DIFF_SUB).transpose(0, 2, 3, 1, 4)
    k = k.reshape(B, S, H, 2, DIFF_SUB).transpose(0, 2, 3, 1, 4)
    v = v.reshape(B, S, H, HEAD_DIM).transpose(0, 2, 1, 3)
    q = apply_partial_rope(q, cos, sin)
    k = apply_partial_rope(k, cos, sin)
    C = DIFF_Q_CHUNK
    nq = S // C
    q_blocks = jnp.moveaxis(q.reshape(B, H, 2, nq, C, DIFF_SUB), 3, 0)
    kpos = jnp.arange(S)

    def one_block(args):
        q_blk, i = args
        s = jnp.einsum('bhjcd,bhjkd->bhjck', q_blk, k,
                       preferred_element_type=jnp.float32) * DIFF_SCALE
        qpos = i * C + jnp.arange(C)
        s = jnp.where(kpos[None, :] <= qpos[:, None], s, -jnp.inf)
        p = jax.nn.softmax(s, axis=-1)
        a = p[:, :, 0] - lam * p[:, :, 1]
        return jnp.einsum('bhck,bhkd->bhcd', a.astype(v.dtype), v)

    o = lax.map(one_block, (q_blocks, jnp.arange(nq)))
    o = jnp.moveaxis(o, 0, 2).reshape(B, H, S, HEAD_DIM)
    of = o.astype(jnp.float32)
    of = of * lax.rsqrt(jnp.mean(jnp.square(of), axis=-1, keepdims=True) + RMS_EPS)
    of = of * subln_g.astype(jnp.float32) * (1.0 - lam_init)
    return of.astype(v.dtype).transpose(0, 2, 1, 3).reshape(B, S, DIFF_W)


def moba_attention(q, k, v, cos, sin):
    B, S = q.shape[0], q.shape[1]
    H = N_MOBA_HEADS
    q = q.reshape(B, S, H, HEAD_DIM).transpose(0, 2, 1, 3)
    k = k.reshape(B, S, H, HEAD_DIM).transpose(0, 2, 1, 3)
    v = v.reshape(B, S, H, HEAD_DIM).transpose(0, 2, 1, 3)
    q = apply_partial_rope(q, cos, sin)
    k = apply_partial_rope(k, cos, sin)
    NB = -(-S // MOBA_BLOCK)
    S_pad = NB * MOBA_BLOCK
    K_SEL = min(MOBA_TOPK, NB)
    pad = ((0, 0), (0, 0), (0, S_pad - S), (0, 0))
    k_pad = jnp.pad(k, pad)
    v_pad = jnp.pad(v, pad)
    kb = k_pad.reshape(B, H, NB, MOBA_BLOCK, HEAD_DIM)
    vb = v_pad.reshape(B, H, NB, MOBA_BLOCK, HEAD_DIM)
    counts = jnp.minimum(MOBA_BLOCK, S - jnp.arange(NB) * MOBA_BLOCK).astype(jnp.float32)
    kmean = jnp.sum(kb.astype(jnp.float32), axis=3) / counts[None, None, :, None]
    gate = jnp.einsum('bhsd,bhnd->bhsn', q.astype(jnp.float32), kmean)
    qblk = jnp.arange(S) // MOBA_BLOCK
    past = jnp.arange(NB)[None, :] < qblk[:, None]
    gate = jnp.where(past, gate, -jnp.inf)
    top_val, top_idx = lax.top_k(gate, K_SEL)
    top_valid = jnp.isfinite(top_val)

    C = MOBA_Q_CHUNK
    nc = S // C
    q_c = jnp.moveaxis(q.reshape(B, H, nc, C, HEAD_DIM), 2, 0)
    idx_c = jnp.moveaxis(top_idx.reshape(B, H, nc, C, K_SEL), 2, 0)
    val_c = jnp.moveaxis(top_valid.reshape(B, H, nc, C, K_SEL), 2, 0)
    bi = jnp.arange(B)[:, None, None, None]
    hi = jnp.arange(H)[None, :, None, None]

    def one_chunk(args):
        qc, ic, vc, i = args
        start = i * C
        blk_start = (start // MOBA_BLOCK) * MOBA_BLOCK
        k_own = lax.dynamic_slice_in_dim(k_pad, blk_start, MOBA_BLOCK, axis=2)
        v_own = lax.dynamic_slice_in_dim(v_pad, blk_start, MOBA_BLOCK, axis=2)
        qpos = start + jnp.arange(C)
        kpos = blk_start + jnp.arange(MOBA_BLOCK)
        s_own = jnp.einsum('bhcd,bhkd->bhck', qc, k_own,
                           preferred_element_type=jnp.float32) * MOBA_SCALE
        s_own = jnp.where(kpos[None, :] <= qpos[:, None], s_own, -jnp.inf)
        k_sel = kb[bi, hi, ic]
        v_sel = vb[bi, hi, ic]
        s_sel = jnp.einsum('bhcd,bhcjkd->bhcjk', qc, k_sel,
                           preferred_element_type=jnp.float32) * MOBA_SCALE
        s_sel = jnp.where(vc[..., None], s_sel, -jnp.inf)
        s_sel = s_sel.reshape(B, H, C, K_SEL * MOBA_BLOCK)
        p = jax.nn.softmax(jnp.concatenate([s_own, s_sel], axis=-1), axis=-1)
        p_own = p[..., :MOBA_BLOCK].astype(v.dtype)
        p_sel = p[..., MOBA_BLOCK:].reshape(B, H, C, K_SEL, MOBA_BLOCK).astype(v.dtype)
        return (jnp.einsum('bhck,bhkd->bhcd', p_own, v_own)
                + jnp.einsum('bhcjk,bhcjkd->bhcd', p_sel, v_sel))

    o = lax.map(one_chunk, (q_c, idx_c, val_c, jnp.arange(nc)))
    o = jnp.moveaxis(o, 0, 2).reshape(B, H, S, HEAD_DIM)
    return o.transpose(0, 2, 1, 3).reshape(B, S, MOBA_W)


def conv_ffn(h, w_up, conv_w, conv_b, w_down):
    u = h @ w_up
    g, val = u[..., :FFN_DIM], u[..., FFN_DIM:]
    S = h.shape[1]
    gp = jnp.pad(g, ((0, 0), (CONV_W - 1, 0), (0, 0)))
    gc = conv_b + sum(conv_w[j] * gp[:, j:j + S] for j in range(CONV_W))
    return (jax.nn.silu(gc) * val) @ w_down


def setup_inputs(seed: int = 0) -> dict:
    key = jax.random.key(seed)
    ks = jax.random.split(key, 16)
    f32 = jnp.float32
    x = jax.random.normal(ks[0], (BATCH, SEQ, D_MODEL), f32)
    w_in = jax.random.normal(ks[1], (DEPTH, D_MODEL, IN_COLS), f32) * D_MODEL ** -0.5
    col_scale = np.ones((IN_COLS,), np.float32)
    col_scale[2 * DIFF_W:3 * DIFF_W] = DEEPNORM_BETA
    col_scale[3 * DIFF_W + 2 * MOBA_W:] = DEEPNORM_BETA
    w_in = w_in * jnp.asarray(col_scale)
    lambda_q1 = jax.random.normal(ks[2], (DEPTH, DIFF_SUB), f32) * 0.1
    lambda_k1 = jax.random.normal(ks[3], (DEPTH, DIFF_SUB), f32) * 0.1
    lambda_q2 = jax.random.normal(ks[4], (DEPTH, DIFF_SUB), f32) * 0.1
    lambda_k2 = jax.random.normal(ks[5], (DEPTH, DIFF_SUB), f32) * 0.1
    subln_g = 1.0 + 0.02 * jax.random.normal(ks[6], (DEPTH, HEAD_DIM), f32)
    w_out = jax.random.normal(ks[7], (DEPTH, MIX_W, D_MODEL), f32) * (MIX_W ** -0.5 * DEEPNORM_BETA)
    ln1_g = 1.0 + 0.02 * jax.random.normal(ks[8], (DEPTH, D_MODEL), f32)
    ln1_b = 0.02 * jax.random.normal(ks[9], (DEPTH, D_MODEL), f32)
    w_up = jax.random.normal(ks[10], (DEPTH, D_MODEL, 2 * FFN_DIM), f32) * (D_MODEL ** -0.5 * DEEPNORM_BETA)
    conv_w = jax.random.normal(ks[11], (DEPTH, CONV_W, FFN_DIM), f32) * CONV_W ** -0.5
    conv_b = 0.02 * jax.random.normal(ks[12], (DEPTH, FFN_DIM), f32)
    w_down = jax.random.normal(ks[13], (DEPTH, FFN_DIM, D_MODEL), f32) * (FFN_DIM ** -0.5 * DEEPNORM_BETA)
    ln2_g = 1.0 + 0.02 * jax.random.normal(ks[14], (DEPTH, D_MODEL), f32)
    ln2_b = 0.02 * jax.random.normal(ks[15], (DEPTH, D_MODEL), f32)
    return {"x": x, "w_in": w_in, "lambda_q1": lambda_q1, "lambda_k1": lambda_k1,
            "lambda_q2": lambda_q2, "lambda_k2": lambda_k2, "subln_g": subln_g,
            "w_out": w_out, "ln1_g": ln1_g, "ln1_b": ln1_b, "w_up": w_up,
            "conv_w": conv_w, "conv_b": conv_b, "w_down": w_down,
            "ln2_g": ln2_g, "ln2_b": ln2_b}


def reference(x, w_in, lambda_q1, lambda_k1, lambda_q2, lambda_k2, subln_g, w_out,
              ln1_g, ln1_b, w_up, conv_w, conv_b, w_down, ln2_g, ln2_b):
    S = x.shape[1]
    cos_d, sin_d = rope_tables(S, DIFF_SUB // ROT_FRACTION)
    cos_m, sin_m = rope_tables(S, HEAD_DIM // ROT_FRACTION)
    h = x
    for l in range(DEPTH):
        lam_init = 0.8 - 0.6 * math.exp(-0.3 * l)
        lam = (jnp.exp(jnp.sum(lambda_q1[l].astype(jnp.float32) * lambda_k1[l].astype(jnp.float32)))
               - jnp.exp(jnp.sum(lambda_q2[l].astype(jnp.float32) * lambda_k2[l].astype(jnp.float32)))
               + lam_init)
        proj = h @ w_in[l]
        o0 = 0
        q_d = proj[..., o0:o0 + DIFF_W]; o0 += DIFF_W
        k_d = proj[..., o0:o0 + DIFF_W]; o0 += DIFF_W
        v_d = proj[..., o0:o0 + DIFF_W]; o0 += DIFF_W
        q_m = proj[..., o0:o0 + MOBA_W]; o0 += MOBA_W
        k_m = proj[..., o0:o0 + MOBA_W]; o0 += MOBA_W
        v_m = proj[..., o0:o0 + MOBA_W]
        a_out = diff_attention(q_d, k_d, v_d, lam, lam_init, subln_g[l], cos_d, sin_d)
        b_out = moba_attention(q_m, k_m, v_m, cos_m, sin_m)
        mix = jnp.concatenate([a_out, b_out], axis=-1) @ w_out[l]
        h = layer_norm(DEEPNORM_ALPHA * h + mix, ln1_g[l], ln1_b[l])
        f = conv_ffn(h, w_up[l], conv_w[l], conv_b[l], w_down[l])
        h = layer_norm(DEEPNORM_ALPHA * h + f, ln2_g[l], ln2_b[l])
    return h
```

```cpp
#include <hip/hip_runtime.h>
#include <hip/hip_cooperative_groups.h>
#include <cstdio>
#include <cstdint>
#include <cmath>
namespace cg = cooperative_groups;
#ifndef MK_N_LAUNCHES
#define MK_N_LAUNCHES 1
#endif
namespace pg8 {
#define PG8_LAS __attribute__((address_space(3)))
typedef unsigned short bf16_t;
typedef short bf16x8 __attribute__((ext_vector_type(8)));
typedef float f32x4 __attribute__((ext_vector_type(4)));
typedef unsigned u32x4 __attribute__((ext_vector_type(4)));
constexpr int BM = 256, BK = 64, HALF = 128, HTB = HALF * BK * 2  , STAGE_BYTES = 8 * HTB, NXCD = 8, WGM = 8;

__host__ __device__ __forceinline__ int lds_byte(int r, int c) { const int st = (r >> 4) * 2 + (c >> 5), rr = r & 15, cc = c & 31, ob = rr * 64 + cc * 2; return st * 1024 + (ob ^ (((ob >> 9) & 1) << 5)); }
__host__ __device__ __forceinline__ void stage_rc(int b, int& R, int& C) { const int st = b / 1024, sb = b % 1024, swz = sb ^ (((sb >> 9) & 1) << 5); R = (st >> 1) * 16 + swz / 64; C = (st & 1) * 32 + (swz % 64) / 2; }
__host__ __device__ __forceinline__ int perm32(int rho) { const int n = rho >> 4, i = rho & 15; return 8 * (i >> 2) + 4 * n + (i & 3); }

struct Unit { int pm, pn; };
struct Gemm { const bf16_t* A; const bf16_t* Bt; int M, N, K, lda; };

struct StaticOrder {
    int nM, nN, nwg, G, c;
    __host__ __device__ void init(int M, int N, int G_, int c_) { nM = M / BM; nN = N / BM; nwg = nM * nN; G = G_; c = c_; }
    __host__ __device__ bool next(int i, Unit& u) const {
        const long L = (long)i * G + c; if (L >= nwg) return false;
        int wgid = (int)L; { const int q = nwg / NXCD, r = nwg % NXCD, xcd = wgid % NXCD, off = wgid / NXCD; wgid = (xcd < r ? xcd * (q + 1) : r * (q + 1) + (xcd - r) * q) + off; }
        const int nig = WGM * nN, gid = wgid / nig, fm = gid * WGM, gsz = (nM - fm) < WGM ? (nM - fm) : WGM;
        u.pm = fm + ((wgid % nig) % gsz); u.pn = (wgid % nig) / gsz; return true;
    }
    __device__ __forceinline__ void a_ready(const Unit&) const {}
    __device__ __forceinline__ void done(const Unit&) const {}
};

__device__ __forceinline__ unsigned cvt_pk_bf16(float lo, float hi) { unsigned r; asm volatile("v_cvt_pk_bf16_f32 %0, %1, %2" : "=v"(r) : "v"(lo), "v"(hi)); return r; }
typedef float f32x2 __attribute__((ext_vector_type(2)));
typedef float f32x2 __attribute__((ext_vector_type(2)));
typedef __bf16 bf16x2_t __attribute__((ext_vector_type(2)));
__device__ __forceinline__ unsigned pk_bf16(float lo, float hi) { f32x2 v = {lo, hi}; bf16x2_t b = __builtin_convertvector(v, bf16x2_t); return __builtin_bit_cast(unsigned, b); }

struct EpiPlainBf16 {
    static constexpr bool PERM = true, AFTER_DRAIN = false;
    bf16_t* O; int ldc;
    __device__ __forceinline__ void operator()(const f32x4 (&acc)[2][2][4][2], const Unit& u, int wr, int wc, int fr, int fq) const {
        const int row0 = u.pm * BM + wr * 64 + fr, col0 = u.pn * BM + wc * 32 + 8 * fq;
#pragma unroll
        for (int ai = 0; ai < 2; ++ai)
#pragma unroll
            for (int m = 0; m < 4; ++m) { bf16_t* rowp = O + (size_t)(row0 + ai * HALF + m * 16) * ldc + col0;
#pragma unroll
                for (int bj = 0; bj < 2; ++bj) { const f32x4 v0 = acc[ai][bj][m][0], v1 = acc[ai][bj][m][1];
                    u32x4 w; w.x = pk_bf16(v0[0], v0[1]); w.y = pk_bf16(v0[2], v0[3]); w.z = pk_bf16(v1[0], v1[1]); w.w = pk_bf16(v1[2], v1[3]);
                    *(u32x4*)(rowp + bj * HALF) = w; } }
    }
};

struct EpiProj {
    static constexpr bool PERM = true, AFTER_DRAIN = false;
    bf16_t* O; const float* tabD; const float* tabM; float* kpart; float qscale_d, qscale_m;
    __device__ __forceinline__ void operator()(const f32x4 (&acc)[2][2][4][2], const Unit& u, int wr, int wc, int fr, int fq) const {
        const int region = u.pn >> 2;
        const int row0 = u.pm * BM + wr * 64 + fr, col0 = u.pn * BM + wc * 32 + 8 * fq;
        const bool ropeD = (region <= 1) && ((wc & 1) == 0);
        const bool ropeM = (region == 3 || region == 4) && (wc == 0);
        const float sc = region == 0 ? qscale_d : (region == 3 ? qscale_m : 1.f);
        f32x4 ks[2][2];
#pragma unroll
        for (int bj = 0; bj < 2; ++bj) { ks[bj][0] = (f32x4){0.f, 0.f, 0.f, 0.f}; ks[bj][1] = (f32x4){0.f, 0.f, 0.f, 0.f}; }
#pragma unroll
        for (int ai = 0; ai < 2; ++ai)
#pragma unroll
            for (int m = 0; m < 4; ++m) {
                const int r = row0 + ai * HALF + m * 16, pos = r & 4095;
                f32x4 c0 = {1.f, 1.f, 1.f, 1.f}, c1 = c0, s0 = {0.f, 0.f, 0.f, 0.f}, s1 = s0;
                if (ropeD) { const float* t = tabD + pos * 16; c0 = *(const f32x4*)t; c1 = *(const f32x4*)(t + 4); s0 = *(const f32x4*)(t + 8); s1 = *(const f32x4*)(t + 12); }
                else if (ropeM) { const float* t = tabM + pos * 32 + 8 * (fq & 1); c0 = *(const f32x4*)t; c1 = *(const f32x4*)(t + 4); s0 = *(const f32x4*)(t + 16); s1 = *(const f32x4*)(t + 20); }
                bf16_t* rowp = O + (size_t)r * 6144 + col0;
#pragma unroll
                for (int bj = 0; bj < 2; ++bj) {
                    f32x4 v0 = acc[ai][bj][m][0], v1 = acc[ai][bj][m][1];
                    if (ropeD) {
                        f32x4 p0, p1;
#pragma unroll
                        for (int e = 0; e < 4; ++e) { p0[e] = __shfl_xor(v0[e], 16); p1[e] = __shfl_xor(v1[e], 16); }
                        const f32x4 sg0 = (fq == 0) ? -s0 : s0, sg1 = (fq == 0) ? -s1 : s1;
                        const f32x4 n0 = v0 * c0 + p0 * sg0, n1 = v1 * c1 + p1 * sg1;
                        if (fq < 2) { v0 = n0; v1 = n1; }
                    } else if (ropeM) {
                        f32x4 p0, p1;
#pragma unroll
                        for (int e = 0; e < 4; ++e) { p0[e] = __shfl_xor(v0[e], 32); p1[e] = __shfl_xor(v1[e], 32); }
                        const f32x4 sg0 = (fq < 2) ? -s0 : s0, sg1 = (fq < 2) ? -s1 : s1;
                        v0 = v0 * c0 + p0 * sg0; v1 = v1 * c1 + p1 * sg1;
                    }
                    v0 = v0 * sc; v1 = v1 * sc;
                    ks[bj][0] += v0; ks[bj][1] += v1;
                    u32x4 w; w.x = pk_bf16(v0[0], v0[1]); w.y = pk_bf16(v0[2], v0[3]); w.z = pk_bf16(v1[0], v1[1]); w.w = pk_bf16(v1[2], v1[3]);
                    *(u32x4*)(rowp + bj * HALF) = w;
                }
            }
        if (region == 4) {
#pragma unroll
            for (int bj = 0; bj < 2; ++bj)
#pragma unroll
                for (int n = 0; n < 2; ++n)
#pragma unroll
                    for (int e = 0; e < 4; ++e) { float v = ks[bj][n][e]; v += __shfl_xor(v, 1); v += __shfl_xor(v, 2); v += __shfl_xor(v, 4); v += __shfl_xor(v, 8); ks[bj][n][e] = v; }
            if (fr == 0) {
                float* kp = kpart + (size_t)(u.pm * 2 + wr) * 1024 + (col0 - 4096);
#pragma unroll
                for (int bj = 0; bj < 2; ++bj) { *(f32x4*)(kp + bj * HALF) = ks[bj][0]; *(f32x4*)(kp + bj * HALF + 4) = ks[bj][1]; }
            }
        }
    }
};

struct EpiResid {
    static constexpr bool PERM = false, AFTER_DRAIN = false;
    const float* base; float* out; int ldc; float alpha;
    __device__ __forceinline__ void operator()(const f32x4 (&acc)[2][2][4][2], const Unit& u, int wr, int wc, int fr, int fq) const {
        const int col0 = u.pn * BM + wc * 32 + 4 * fq;
#pragma unroll
        for (int ai = 0; ai < 2; ++ai)
#pragma unroll
            for (int m = 0; m < 4; ++m) { const size_t off = (size_t)(u.pm * BM + ai * HALF + wr * 64 + m * 16 + fr) * ldc + col0;
#pragma unroll
                for (int bj = 0; bj < 2; ++bj)
#pragma unroll
                    for (int n = 0; n < 2; ++n) { const f32x4 bs = *(const f32x4*)(base + off + bj * HALF + n * 16); *(f32x4*)(out + off + bj * HALF + n * 16) = bs * alpha + acc[ai][bj][m][n]; } }
    }
};

template <class Epi, class Sched, bool ALIGN_EPI = false, bool SP2 = false>
__device__ __forceinline__ void gemm_phase(PG8_LAS unsigned char* lds, const Gemm g, const Sched& S, const Epi& E) {
    const int tid = threadIdx.x, wid = __builtin_amdgcn_readfirstlane(tid >> 6), lane = tid & 63, wr = wid >> 2, wc = wid & 3, fr = lane & 15, fq = lane >> 4;
    const int K = g.K, nt = K / BK;
    unsigned voffA[2], voffB[2];
#pragma unroll
    for (int i = 0; i < 2; ++i) { int R, C; stage_rc(tid * 16 + i * 8192, R, C); const int Rb = Epi::PERM ? ((R & ~31) + perm32(R & 31)) : R;
        voffA[i] = (unsigned)(R * g.lda + C) * 2u; voffB[i] = (unsigned)(Rb * K + C) * 2u; }
    const size_t kstep = (size_t)(BK * 2);
    const size_t hstepB = (size_t)HALF * K * 2, hstepA = (size_t)HALF * g.lda * 2;
    const size_t tstepB = 2 * hstepB, tstepA = 2 * hstepA;
    const unsigned ldsw = (unsigned)wid * 1024u;
    const int aoff = lds_byte(wr * 64 + fr, fq * 8), boff = lds_byte(wc * 32 + fr, fq * 8);
#define PG8_SA(b, h) (((b) * 2 + (h)) * HTB)
#define PG8_SB(b, h) ((4 + (b) * 2 + (h)) * HTB)
#define PG8_STAGE(bufoff, gbase, voff) do { _Pragma("unroll") for (int _i = 0; _i < 2; ++_i) \
        __builtin_amdgcn_global_load_lds((const unsigned*)((const char*)(gbase) + (voff)[_i]), (PG8_LAS unsigned*)(lds + (bufoff) + ldsw + _i * 8192), 16, 0, 0); } while (0)
#define PG8_LDA(dst, b, h) do { _Pragma("unroll") for (int m = 0; m < 4; ++m) _Pragma("unroll") for (int k = 0; k < 2; ++k) dst[m][k] = *(const PG8_LAS bf16x8*)(lds + PG8_SA(b, h) + aoff + m * 2048 + k * 1024); } while (0)
#define PG8_LDB(dst, b, h) do { _Pragma("unroll") for (int n = 0; n < 2; ++n) _Pragma("unroll") for (int k = 0; k < 2; ++k) dst[n][k] = *(const PG8_LAS bf16x8*)(lds + PG8_SB(b, h) + boff + n * 2048 + k * 1024); } while (0)
#define PG8_MMA(ai, bj, At, Bt) do { __builtin_amdgcn_s_setprio(1); _Pragma("unroll") for (int m = 0; m < 4; ++m) _Pragma("unroll") for (int n = 0; n < 2; ++n) _Pragma("unroll") for (int k = 0; k < 2; ++k) \
        acc[ai][bj][m][n] = __builtin_amdgcn_mfma_f32_16x16x32_bf16(Bt[n][k], At[m][k], acc[ai][bj][m][n], 0, 0, 0); __builtin_amdgcn_s_setprio(0); } while (0)
#define PG8_WAIT_V(n) asm volatile("s_waitcnt vmcnt(" #n ")" ::: "memory")
#define PG8_WAIT_L(n) asm volatile("s_waitcnt lgkmcnt(" #n ")" ::: "memory")
#define PG8_BAR __builtin_amdgcn_s_barrier()
#define PG8_SCHED __builtin_amdgcn_sched_barrier(0)
    Unit cur, nxt; int ui = 0;
    if (!S.next(0, cur)) return;
    f32x4 acc[2][2][4][2];
#pragma unroll
    for (int a = 0; a < 2; ++a)
#pragma unroll
        for (int b = 0; b < 2; ++b)
#pragma unroll
            for (int m = 0; m < 4; ++m)
#pragma unroll
                for (int n = 0; n < 2; ++n) acc[a][b][m][n] = (f32x4){0.f, 0.f, 0.f, 0.f};
    bf16x8 At[4][2], B0[2][2], B1[2][2];
    const char* cA = (const char*)g.A + (size_t)cur.pm * tstepA; const char* cB = (const char*)g.Bt + (size_t)cur.pn * tstepB;
    S.a_ready(cur);
    if constexpr (SP2) {
        PG8_STAGE(PG8_SB(0, 0), cB, voffB); PG8_STAGE(PG8_SB(0, 1), cB + hstepB, voffB); PG8_STAGE(PG8_SA(0, 0), cA, voffA); PG8_STAGE(PG8_SA(0, 1), cA + hstepA, voffA);
        if (wr == 1) PG8_BAR;
        PG8_WAIT_V(2); PG8_BAR;
        PG8_STAGE(PG8_SB(1, 0), cB + kstep, voffB); PG8_STAGE(PG8_SA(1, 0), cA + kstep, voffA); PG8_STAGE(PG8_SB(1, 1), cB + hstepB + kstep, voffB);
        PG8_WAIT_V(6); PG8_BAR;
    } else {
        PG8_STAGE(PG8_SB(0, 0), cB, voffB); PG8_STAGE(PG8_SA(0, 0), cA, voffA); PG8_STAGE(PG8_SB(0, 1), cB + hstepB, voffB); PG8_STAGE(PG8_SA(0, 1), cA + hstepA, voffA);
        if (wr == 1) PG8_BAR;
        PG8_WAIT_V(4); PG8_BAR;
        PG8_STAGE(PG8_SB(1, 0), cB + kstep, voffB); PG8_STAGE(PG8_SA(1, 0), cA + kstep, voffA); PG8_STAGE(PG8_SB(1, 1), cB + hstepB + kstep, voffB);
        PG8_WAIT_V(6); PG8_BAR;
    }
    for (;;) {
        const bool has_next = S.next(ui + 1, nxt);
        const char* nA = has_next ? (const char*)g.A + (size_t)nxt.pm * tstepA : cA; const char* nB = has_next ? (const char*)g.Bt + (size_t)nxt.pn * tstepB : cB;
        for (int t = 0; t < nt; t += 2) {
            const bool last = (t == nt - 2);
            const char* a1 = cA + (size_t)(t + 1) * kstep;
            const char* a2 = last ? nA : cA + (size_t)(t + 2) * kstep; const char* b2 = last ? nB : cB + (size_t)(t + 2) * kstep;
            const char* a3 = a2 + kstep; const char* b3 = b2 + kstep;
            if (last && has_next) S.a_ready(nxt);
            if constexpr (SP2) {
            PG8_LDB(B0, 0, 0); PG8_LDB(B1, 0, 1); PG8_SCHED; PG8_LDA(At, 0, 0); PG8_STAGE(PG8_SA(1, 1), a1 + hstepA, voffA);
            PG8_WAIT_V(8); PG8_WAIT_L(0); PG8_BAR; PG8_MMA(0, 0, At, B0); PG8_MMA(0, 1, At, B1); PG8_BAR; PG8_SCHED;
            PG8_LDA(At, 0, 1); PG8_STAGE(PG8_SB(0, 0), b2, voffB); PG8_STAGE(PG8_SB(0, 1), b2 + hstepB, voffB); PG8_STAGE(PG8_SA(0, 0), a2, voffA);
            PG8_WAIT_V(8); PG8_WAIT_L(0); PG8_BAR; PG8_MMA(1, 0, At, B0); PG8_MMA(1, 1, At, B1); PG8_BAR; PG8_SCHED;
            PG8_LDB(B0, 1, 0); PG8_LDB(B1, 1, 1); PG8_SCHED; PG8_LDA(At, 1, 0); PG8_STAGE(PG8_SA(0, 1), a2 + hstepA, voffA);
            PG8_WAIT_V(8); PG8_WAIT_L(0); PG8_BAR; PG8_MMA(0, 0, At, B0); PG8_MMA(0, 1, At, B1); PG8_BAR; PG8_SCHED;
            PG8_LDA(At, 1, 1); PG8_STAGE(PG8_SB(1, 0), b3, voffB); PG8_STAGE(PG8_SB(1, 1), b3 + hstepB, voffB); PG8_STAGE(PG8_SA(1, 0), a3, voffA);
            PG8_WAIT_V(8); PG8_WAIT_L(0); PG8_BAR; PG8_MMA(1, 0, At, B0); PG8_MMA(1, 1, At, B1); PG8_BAR; PG8_SCHED;
            } else {
            PG8_LDB(B0, 0, 0); PG8_SCHED; PG8_LDA(At, 0, 0); PG8_STAGE(PG8_SA(1, 1), a1 + hstepA, voffA);
            PG8_WAIT_L(8); PG8_BAR; PG8_WAIT_L(0); PG8_MMA(0, 0, At, B0); PG8_BAR; PG8_SCHED;
            PG8_LDB(B1, 0, 1); PG8_STAGE(PG8_SB(0, 0), b2, voffB);
            PG8_BAR; PG8_WAIT_L(0); PG8_MMA(0, 1, At, B1); PG8_BAR;
            PG8_LDA(At, 0, 1); PG8_STAGE(PG8_SA(0, 0), a2, voffA);
            PG8_BAR; PG8_WAIT_L(0); PG8_MMA(1, 0, At, B0); PG8_BAR; PG8_SCHED;
            PG8_STAGE(PG8_SB(0, 1), b2 + hstepB, voffB);
            PG8_WAIT_V(6); PG8_BAR; PG8_MMA(1, 1, At, B1); PG8_BAR;
            PG8_LDB(B0, 1, 0); PG8_SCHED; PG8_LDA(At, 1, 0); PG8_STAGE(PG8_SA(0, 1), a2 + hstepA, voffA);
            PG8_WAIT_L(8); PG8_BAR; PG8_WAIT_L(0); PG8_MMA(0, 0, At, B0); PG8_BAR; PG8_SCHED;
            PG8_LDB(B1, 1, 1); PG8_STAGE(PG8_SB(1, 0), b3, voffB);
            PG8_BAR; PG8_WAIT_L(0); PG8_MMA(0, 1, At, B1); PG8_BAR;
            PG8_LDA(At, 1, 1); PG8_STAGE(PG8_SA(1, 0), a3, voffA);
            PG8_BAR; PG8_WAIT_L(0); PG8_MMA(1, 0, At, B0); PG8_BAR; PG8_SCHED;
            PG8_STAGE(PG8_SB(1, 1), b3 + hstepB, voffB);
            PG8_WAIT_V(6); PG8_BAR; PG8_MMA(1, 1, At, B1); PG8_BAR;
            }
        }
        if constexpr (ALIGN_EPI) { if (wr == 0) PG8_BAR; }
        if constexpr (!Epi::AFTER_DRAIN) { E(acc, cur, wr, wc, fr, fq); S.done(cur); }
        if (!has_next) break;
#pragma unroll
        for (int a = 0; a < 2; ++a)
#pragma unroll
            for (int b = 0; b < 2; ++b)
#pragma unroll
                for (int m = 0; m < 4; ++m)
#pragma unroll
                    for (int n = 0; n < 2; ++n) acc[a][b][m][n] = (f32x4){0.f, 0.f, 0.f, 0.f};
        cur = nxt; cA = nA; cB = nB; ++ui;
        if constexpr (ALIGN_EPI) { if (wr == 1) PG8_BAR; }
    }
    PG8_WAIT_V(0);
    if constexpr (!ALIGN_EPI) { if (wr == 0) PG8_BAR; }
    PG8_BAR;
    if constexpr (Epi::AFTER_DRAIN) { E.fused(acc, cur, wr, wc, fr, fq, lds, wid, lane); S.done(cur); }
#undef PG8_SA
#undef PG8_SB
#undef PG8_STAGE
#undef PG8_LDA
#undef PG8_LDB
#undef PG8_MMA
#undef PG8_WAIT_V
#undef PG8_WAIT_L
#undef PG8_BAR
#undef PG8_SCHED
}
}
namespace att {
#define LAS __attribute__((address_space(3)))
typedef unsigned short bf16_t;
typedef short bf16x8 __attribute__((ext_vector_type(8)));
typedef short s16x4 __attribute__((ext_vector_type(4)));
typedef float f32x4 __attribute__((ext_vector_type(4)));
typedef float f32x16 __attribute__((ext_vector_type(16)));
typedef unsigned u32x4 __attribute__((ext_vector_type(4)));
typedef unsigned u32x2 __attribute__((ext_vector_type(2)));
constexpr int PITCH = 6144;
constexpr int AOP = 2048;
constexpr int OFF_K = 0, OFF_V = 32768, OFF_KM = 65536, OFF_SLOT = 65536 + 8192;
constexpr float NEG = -1.0e30f;
__device__ __forceinline__ int toff(int row, int ch) { return 2048 * (row >> 3) + 512 * (ch >> 2) + 64 * (row & 7) + 16 * ((ch & 3) ^ ((row >> 2) & 3)); }
__device__ __forceinline__ float xsum32(float v) { auto rr = __builtin_amdgcn_permlane32_swap(__float_as_uint(v), __float_as_uint(v), false, false); return __uint_as_float(rr[0]) + __uint_as_float(rr[1]); }
__device__ __forceinline__ float xmax32(float v) { auto rr = __builtin_amdgcn_permlane32_swap(__float_as_uint(v), __float_as_uint(v), false, false); return fmaxf(__uint_as_float(rr[0]), __uint_as_float(rr[1])); }
__device__ __forceinline__ float bf2f(short x) { return __uint_as_float(((unsigned)(unsigned short)x) << 16); }
__device__ __forceinline__ s16x4 vtr(LAS const unsigned char* p) { typedef short v4i16_t __attribute__((ext_vector_type(4))); return __builtin_bit_cast(s16x4, __builtin_amdgcn_ds_read_tr16_b64_v4i16((LAS v4i16_t*)p)); }

struct TileRegs { u32x4 k0, k1, v0, v1; };
__device__ __forceinline__ void tile_load(TileRegs& R, const bf16_t* Kg, const bf16_t* Vg, int tid) {
    const int r0 = tid >> 4, ch = tid & 15;
    R.k0 = *(const u32x4*)(Kg + (size_t)r0 * PITCH + 8 * ch); R.k1 = *(const u32x4*)(Kg + (size_t)(r0 + 32) * PITCH + 8 * ch);
    R.v0 = *(const u32x4*)(Vg + (size_t)r0 * PITCH + 8 * ch); R.v1 = *(const u32x4*)(Vg + (size_t)(r0 + 32) * PITCH + 8 * ch);
}
__device__ __forceinline__ void tile_store(const TileRegs& R, LAS unsigned char* kb, LAS unsigned char* vb, int tid) {
    const int r0 = tid >> 4, ch = tid & 15, o0 = toff(r0, ch);
    *(LAS u32x4*)(kb + o0) = R.k0; *(LAS u32x4*)(kb + o0 + 8192) = R.k1;
    *(LAS u32x4*)(vb + o0) = R.v0; *(LAS u32x4*)(vb + o0 + 8192) = R.v1;
}

template <int NS>
__device__ __forceinline__ void tile_compute(f32x16 (&o)[4], float& m, float& l, const bf16x8 (&qf)[NS], LAS const unsigned char* kb, LAS const unsigned char* vb,
                                             int kch0, int lane, bool causal, int qd, bool lane_sel) {
    const int l32 = lane & 31, hi = lane >> 5;
    const int kx = (l32 >> 2) & 3;
    LAS const unsigned char* kbase0 = kb + 2048 * (l32 >> 3) + 64 * (l32 & 7) + 512 * (kch0 >> 2) + 16 * (hi ^ kx);
    LAS const unsigned char* kbase1 = kb + 2048 * (l32 >> 3) + 64 * (l32 & 7) + 512 * (kch0 >> 2) + 16 * ((2 + hi) ^ kx);
    f32x16 st[2];
#pragma unroll
    for (int b = 0; b < 2; ++b) {
#pragma unroll
        for (int r = 0; r < 16; ++r) st[b][r] = 0.f;
#pragma unroll
        for (int s = 0; s < NS; ++s) {
            const bf16x8 kf = *(LAS const bf16x8*)(((s & 1) ? kbase1 : kbase0) + 8192 * b + 512 * (s >> 1));
            st[b] = __builtin_amdgcn_mfma_f32_32x32x16_bf16(kf, qf[s], st[b], 0, 0, 0);
        }
        __builtin_amdgcn_sched_barrier(0);
    }
    if (causal) {
#pragma unroll
        for (int b = 0; b < 2; ++b)
#pragma unroll
            for (int r = 0; r < 16; ++r) { const int key = 32 * b + (r & 3) + 8 * (r >> 2) + 4 * hi; if (key > qd) st[b][r] = NEG; }
    }
#pragma unroll
    for (int b = 0; b < 2; ++b)
#pragma unroll
        for (int r = 0; r < 16; ++r) st[b][r] = lane_sel ? st[b][r] : NEG;
    float rmax = st[0][0];
#pragma unroll
    for (int b = 0; b < 2; ++b)
#pragma unroll
        for (int r = 0; r < 16; ++r) rmax = fmaxf(rmax, st[b][r]);
    rmax = xmax32(rmax);
    const float mn = fmaxf(m, rmax);
    const float al = __builtin_amdgcn_exp2f(m - mn);
    m = mn;
    float sum = 0.f;
#pragma unroll
    for (int b = 0; b < 2; ++b)
#pragma unroll
        for (int r = 0; r < 16; ++r) { const float p = __builtin_amdgcn_exp2f(st[b][r] - mn); st[b][r] = p; sum += p; }
    l = l * al + sum;
#pragma unroll
    for (int d = 0; d < 4; ++d) o[d] = o[d] * al;
    bf16x8 pf[2][2];
#pragma unroll
    for (int b = 0; b < 2; ++b)
#pragma unroll
        for (int j = 0; j < 2; ++j) { u32x4 w; w.x = pg8::pk_bf16(st[b][8 * j + 0], st[b][8 * j + 1]); w.y = pg8::pk_bf16(st[b][8 * j + 2], st[b][8 * j + 3]);
            w.z = pg8::pk_bf16(st[b][8 * j + 4], st[b][8 * j + 5]); w.w = pg8::pk_bf16(st[b][8 * j + 6], st[b][8 * j + 7]); pf[b][j] = __builtin_bit_cast(bf16x8, w); }
    const int half = (lane >> 4) & 1, qp = (lane & 15) >> 2, p = lane & 3, c3 = 2 * half + (p >> 1);
    LAS const unsigned char* vbase0 = vb + 64 * (4 * hi + qp) + 16 * (c3 ^ hi) + 8 * (p & 1);
    LAS const unsigned char* vbase1 = vb + 64 * (4 * hi + qp) + 16 * (c3 ^ (2 + hi)) + 8 * (p & 1) + 2048;
#pragma unroll
    for (int d = 0; d < 4; ++d) {
        __builtin_amdgcn_sched_barrier(0);
#pragma unroll
        for (int b = 0; b < 2; ++b)
#pragma unroll
            for (int j = 0; j < 2; ++j) {
                const int co = 2048 * (4 * b + 2 * j) + 512 * d;
                const s16x4 lo = vtr(vbase0 + co), hh = vtr(vbase1 + co);
                const bf16x8 vf = {lo[0], lo[1], lo[2], lo[3], hh[0], hh[1], hh[2], hh[3]};
                o[d] = __builtin_amdgcn_mfma_f32_32x32x16_bf16(vf, pf[b][j], o[d], 0, 0, 0);
            }
    }
    __builtin_amdgcn_sched_barrier(0);
}

__device__ __forceinline__ void diff_unit(int b, int h, int i, const bf16_t* P, bf16_t* AO, float lam, const float* subln_g, LAS unsigned char* lds, int tid) {
    const int lane = tid & 63, wid = __builtin_amdgcn_readfirstlane(tid >> 6), w4 = wid >> 1, j = wid & 1, l32 = lane & 31, hi = lane >> 5;
    const size_t rowbase = (size_t)b * 4096; const int q0 = 128 * i + 32 * w4;
    bf16x8 qf[4];
    { const bf16_t* qp = P + (rowbase + q0 + l32) * PITCH + h * 128 + j * 64 + 8 * hi;
#pragma unroll
      for (int s = 0; s < 4; ++s) qf[s] = *(const bf16x8*)(qp + 16 * s); }
    const bf16_t* Kg = P + rowbase * PITCH + 1024 + h * 128; const bf16_t* Vg = P + rowbase * PITCH + 2048 + h * 128;
    f32x16 o[4];
#pragma unroll
    for (int d = 0; d < 4; ++d)
#pragma unroll
        for (int r = 0; r < 16; ++r) o[d][r] = 0.f;
    float m = NEG, l = 0.f;
    const int NT = 2 * (i + 1);
    TileRegs R;
    tile_load(R, Kg, Vg, tid); tile_store(R, lds + OFF_K, lds + OFF_V, tid); __syncthreads();
    for (int t = 0; t < NT; ++t) {
        const int cur = t & 1;
        if (t + 1 < NT) tile_load(R, Kg + (size_t)(t + 1) * 64 * PITCH, Vg + (size_t)(t + 1) * 64 * PITCH, tid);
        const int key0 = 64 * t;
        if (key0 <= q0 + 31) tile_compute<4>(o, m, l, qf, lds + OFF_K + cur * 16384, lds + OFF_V + cur * 16384, 8 * j, lane, key0 + 63 > q0, q0 + l32 - key0, true);
        if (t + 1 < NT) tile_store(R, lds + OFF_K + (cur ^ 1) * 16384, lds + OFF_V + (cur ^ 1) * 16384, tid);
        __syncthreads();
    }
    const float inv = 1.0f / xsum32(l);
#pragma unroll
    for (int d = 0; d < 4; ++d) o[d] = o[d] * inv;
    LAS float* xb = (LAS float*)lds + w4 * 4096;
    if (j == 1) {
#pragma unroll
        for (int d = 0; d < 4; ++d)
#pragma unroll
            for (int r = 0; r < 16; ++r) xb[(d * 16 + r) * 64 + lane] = o[d][r];
    }
    __syncthreads();
    if (j == 0) {
        float ssq = 0.f;
#pragma unroll
        for (int d = 0; d < 4; ++d)
#pragma unroll
            for (int r = 0; r < 16; ++r) { const float v = o[d][r] - lam * xb[(d * 16 + r) * 64 + lane]; o[d][r] = v; ssq += v * v; }
        ssq = xsum32(ssq);
        const float rn = rsqrtf(ssq * (1.0f / 128.0f) + 1e-5f) * 0.8f;
        bf16_t* op = AO + (rowbase + q0 + l32) * AOP + h * 128 + 4 * hi;
#pragma unroll
        for (int d = 0; d < 4; ++d)
#pragma unroll
            for (int g = 0; g < 4; ++g) { const f32x4 gg = *(const f32x4*)(subln_g + 32 * d + 8 * g + 4 * hi);
                u32x2 w; w.x = pg8::pk_bf16(o[d][4 * g] * rn * gg[0], o[d][4 * g + 1] * rn * gg[1]); w.y = pg8::pk_bf16(o[d][4 * g + 2] * rn * gg[2], o[d][4 * g + 3] * rn * gg[3]);
                *(u32x2*)(op + 32 * d + 8 * g) = w; }
    }
    __syncthreads();
}

__device__ __forceinline__ void moba_unit(int b, int h, int blk, const bf16_t* P, bf16_t* AO, const float* kpart, LAS unsigned char* lds, int tid) {
    const int lane = tid & 63, wid = __builtin_amdgcn_readfirstlane(tid >> 6), l32 = lane & 31, hi = lane >> 5;
    const size_t rowbase = (size_t)b * 4096; const int q0 = 256 * blk + 32 * wid;
    bf16x8 qf[8];
    { const bf16_t* qp = P + (rowbase + q0 + l32) * PITCH + 3072 + h * 128 + 8 * hi;
#pragma unroll
      for (int s = 0; s < 8; ++s) qf[s] = *(const bf16x8*)(qp + 16 * s); }
    const bf16_t* Kg = P + rowbase * PITCH + 4096 + h * 128; const bf16_t* Vg = P + rowbase * PITCH + 5120 + h * 128;
    LAS float* km = (LAS float*)(lds + OFF_KM);
    for (int idx = tid; idx < blk * 128; idx += 512) { const int n = idx >> 7, d = idx & 127; const float* kp = kpart + (size_t)((b * 16 + n) * 2) * 1024 + h * 128 + d; km[idx] = kp[0] + kp[1024]; }
    TileRegs R;
    tile_load(R, Kg + (size_t)(256 * blk) * PITCH, Vg + (size_t)(256 * blk) * PITCH, tid); tile_store(R, lds + OFF_K, lds + OFF_V, tid);
    __syncthreads();
    unsigned selmask = 0u;
    {
        float tv0 = -INFINITY, tv1 = -INFINITY, tv2 = -INFINITY; int ti0 = -1, ti1 = -1, ti2 = -1;
        for (int n = 0; n < blk; ++n) {
            float part = 0.f;
#pragma unroll
            for (int s = 0; s < 8; ++s) { const LAS float* kp = km + n * 128 + 16 * s + 8 * hi; const f32x4 ka = *(const LAS f32x4*)kp, kc = *(const LAS f32x4*)(kp + 4);
                part += bf2f(qf[s][0]) * ka[0] + bf2f(qf[s][1]) * ka[1] + bf2f(qf[s][2]) * ka[2] + bf2f(qf[s][3]) * ka[3] + bf2f(qf[s][4]) * kc[0] + bf2f(qf[s][5]) * kc[1] + bf2f(qf[s][6]) * kc[2] + bf2f(qf[s][7]) * kc[3]; }
            const float tot = xsum32(part);
            if (tot > tv0) { tv2 = tv1; ti2 = ti1; tv1 = tv0; ti1 = ti0; tv0 = tot; ti0 = n; }
            else if (tot > tv1) { tv2 = tv1; ti2 = ti1; tv1 = tot; ti1 = n; }
            else if (tot > tv2) { tv2 = tot; ti2 = n; }
        }
        if (ti0 >= 0) selmask |= 1u << ti0; if (ti1 >= 0) selmask |= 1u << ti1; if (ti2 >= 0) selmask |= 1u << ti2;
    }
    f32x16 o[4];
#pragma unroll
    for (int d = 0; d < 4; ++d)
#pragma unroll
        for (int r = 0; r < 16; ++r) o[d][r] = 0.f;
    float m = NEG, l = 0.f;
    const int NT = 4 + 4 * blk;
    for (int t = 0; t < NT; ++t) {
        const int cur = t & 1;
        if (t + 1 < NT) { const int t1 = t + 1; const int key0n = (t1 < 4) ? 256 * blk + 64 * t1 : 64 * (t1 - 4); tile_load(R, Kg + (size_t)key0n * PITCH, Vg + (size_t)key0n * PITCH, tid); }
        bool doit, causal, sel; int qd;
        if (t < 4) { const int kr = 64 * t, qr0 = 32 * wid; doit = kr <= qr0 + 31; causal = kr + 63 > qr0; qd = qr0 + l32 - kr; sel = true; }
        else { const int n = (t - 4) >> 2; sel = (selmask >> n) & 1u; doit = __any(sel); causal = false; qd = 0; }
        if (doit) tile_compute<8>(o, m, l, qf, lds + OFF_K + cur * 16384, lds + OFF_V + cur * 16384, 0, lane, causal, qd, sel);
        if (t + 1 < NT) tile_store(R, lds + OFF_K + (cur ^ 1) * 16384, lds + OFF_V + (cur ^ 1) * 16384, tid);
        __syncthreads();
    }
    const float inv = 1.0f / xsum32(l);
    bf16_t* op = AO + (rowbase + q0 + l32) * AOP + 1024 + h * 128 + 4 * hi;
#pragma unroll
    for (int d = 0; d < 4; ++d)
#pragma unroll
        for (int g = 0; g < 4; ++g) { u32x2 w; w.x = pg8::pk_bf16(o[d][4 * g] * inv, o[d][4 * g + 1] * inv); w.y = pg8::pk_bf16(o[d][4 * g + 2] * inv, o[d][4 * g + 3] * inv); *(u32x2*)(op + 32 * d + 8 * g) = w; }
}
}
#define LAS __attribute__((address_space(3)))
typedef unsigned short bf16;
typedef unsigned v4u __attribute__((ext_vector_type(4)));
typedef unsigned v2u __attribute__((ext_vector_type(2)));
typedef float f32x4 __attribute__((ext_vector_type(4)));
#ifndef SKIPMASK
#define SKIPMASK 0
#endif
constexpr int NWAVES = 8;
constexpr int N_LAUNCHES = MK_N_LAUNCHES;
constexpr int NPH = 9;
constexpr int SEQ = 4096, NB = 4, M = NB * SEQ, D = 2048, NPROJ = 6144, FF = 5632, NUP = 2 * FF;
constexpr float LN_EPS = 1e-5f;
constexpr float ALPHA = 1.189207115002721f;
constexpr float LOG2E = 1.4426950408889634f;
constexpr size_t MiB = 1u << 20;
constexpr size_t WS_CTL = 0;
constexpr size_t WS_TABD = 1 * MiB, WS_TABM = WS_TABD + 4096 * 16 * 4;
constexpr size_t WS_KPART = 2 * MiB;
constexpr size_t WS_WUP = 4 * MiB, WS_WDOWN = 48 * MiB, WS_WIN = 72 * MiB, WS_WOUT = 96 * MiB;
constexpr size_t WS_XB = 104 * MiB, WS_P = 168 * MiB, WS_AO = 360 * MiB;
constexpr size_t WS_U = 96 * MiB;
constexpr size_t WS_H1B = 448 * MiB, WS_END = 512 * MiB;
static_assert(WS_U + (size_t)M * NUP * 2 <= WS_H1B && WS_AO + (size_t)M * D * 2 <= WS_H1B && WS_WIN + (size_t)NPROJ * D * 2 <= WS_WOUT && WS_WDOWN + (size_t)D * FF * 2 <= WS_WIN, "ws map");
constexpr int LDS_BYTES = 147456;
constexpr int LDS_MISC = 131072;

struct Args { const float* in[16]; float* out; unsigned char* ws; float invD[8]; float invM[16]; int ph_lo, ph_hi; };

__device__ __forceinline__ float wave_sum(float v) {
#pragma unroll
    for (int o = 1; o < 64; o <<= 1) v += __shfl_xor(v, o);
    return v;
}
__device__ __forceinline__ void p0_transpose_item(const float* W, int K, int N, bf16* WT, LAS float* scr, int item, int lane) {
    const int nblk = N / 32, kb = item / nblk, nb = item % nblk, k0 = 64 * kb, n0 = 32 * nb;
#pragma unroll 8
    for (int i = 0; i < 32; ++i) { const int kk = 2 * i + (lane >> 5); scr[kk * 33 + (lane & 31)] = W[(size_t)(k0 + kk) * N + n0 + (lane & 31)]; }
    asm volatile("s_waitcnt lgkmcnt(0)" ::: "memory");
    const int c = lane & 7;
#pragma unroll
    for (int j = 0; j < 4; ++j) { const int n = (lane >> 3) + 8 * j; const LAS float* s = scr + (8 * c) * 33 + n;
        v4u o; o.x = pg8::pk_bf16(s[0 * 33], s[1 * 33]); o.y = pg8::pk_bf16(s[2 * 33], s[3 * 33]); o.z = pg8::pk_bf16(s[4 * 33], s[5 * 33]); o.w = pg8::pk_bf16(s[6 * 33], s[7 * 33]);
        *(v4u*)(WT + (size_t)(n0 + n) * K + k0 + 8 * c) = o; }
    asm volatile("s_waitcnt lgkmcnt(0)" ::: "memory");
}
__device__ __forceinline__ void ln_rows(float* io, bf16* ob, const float* g, const float* bta, int gw, int NGW, int lane) {
    for (int m = gw; m < M; m += NGW) {
        f32x4* xr = (f32x4*)(io + (size_t)m * D) + lane;
        f32x4 v[8]; float s = 0.f;
#pragma unroll
        for (int j = 0; j < 8; ++j) { v[j] = xr[64 * j]; s += (v[j].x + v[j].y) + (v[j].z + v[j].w); }
        const float mean = wave_sum(s) * (1.f / D); float s2 = 0.f;
#pragma unroll
        for (int j = 0; j < 8; ++j) { v[j] = v[j] - mean; s2 += (v[j].x * v[j].x + v[j].y * v[j].y) + (v[j].z * v[j].z + v[j].w * v[j].w); }
        const float rstd = rsqrtf(wave_sum(s2) * (1.f / D) + LN_EPS);
#pragma unroll
        for (int j = 0; j < 8; ++j) { const f32x4 gg = *((const f32x4*)g + lane + 64 * j), bb = *((const f32x4*)bta + lane + 64 * j);
            const f32x4 y = v[j] * rstd * gg + bb; xr[64 * j] = y;
            if (ob) { v2u w; w.x = pg8::pk_bf16(y.x, y.y); w.y = pg8::pk_bf16(y.z, y.w); *((v2u*)(ob + (size_t)m * D) + lane + 64 * j) = w; } }
    }
}

__global__ void __launch_bounds__(NWAVES * 64, 2) mega(Args args) {
    extern __shared__ __attribute__((aligned(16))) unsigned char lds_raw[];
    LAS unsigned char* lds = (LAS unsigned char*)lds_raw;
    cg::grid_group grid = cg::this_grid();
    const int G = gridDim.x, bx = blockIdx.x;
#define TIDS() int tid = threadIdx.x; asm volatile("" : "+v"(tid)); const int lane = tid & 63, wave = __builtin_amdgcn_readfirstlane(tid >> 6); const int gw = bx * NWAVES + wave, NGW = G * NWAVES; (void)lane; (void)gw; (void)NGW
    const int lo = args.ph_lo, hi = args.ph_hi;
#define IN(k) (lo <= (k) && (k) < hi)
#define SEAM(k) do { if (IN(k) && IN((k) + 1)) grid.sync(); } while (0)

    if (IN(0) && !(SKIPMASK & (1 << 0))) { TIDS();
        const float* x = args.in[0]; const float* w_in = args.in[1]; const float* w_out = args.in[7]; const float* w_up = args.in[10]; const float* w_down = args.in[13]; unsigned char* ws = args.ws; unsigned* ctl = (unsigned*)(ws + WS_CTL); float* tabD = (float*)(ws + WS_TABD); float* tabM = (float*)(ws + WS_TABM); bf16* Wt_in = (bf16*)(ws + WS_WIN); bf16* Wt_out = (bf16*)(ws + WS_WOUT); bf16* Wt_up = (bf16*)(ws + WS_WUP); bf16* Wt_down = (bf16*)(ws + WS_WDOWN); bf16* XB = (bf16*)(ws + WS_XB);

        if (bx == 0 && tid == 0) ctl[0] = 0u;
        LAS float* scr = (LAS float*)(lds + wave * 16384);
        constexpr int I_IN = (D / 64) * (NPROJ / 32), I_OUT = (D / 64) * (D / 32), I_UP = (D / 64) * (NUP / 32), I_DN = (FF / 64) * (D / 32);
        constexpr int NITEMS = I_IN + I_OUT + I_UP + I_DN;
        for (int it = gw; it < NITEMS; it += NGW) {
            int r = it;
            if (r < I_IN) { p0_transpose_item(w_in, D, NPROJ, Wt_in, scr, r, lane); continue; } r -= I_IN;
            if (r < I_OUT) { p0_transpose_item(w_out, D, D, Wt_out, scr, r, lane); continue; } r -= I_OUT;
            if (r < I_UP) { p0_transpose_item(w_up, D, NUP, Wt_up, scr, r, lane); continue; } r -= I_UP;
            p0_transpose_item(w_down, FF, D, Wt_down, scr, r, lane);
        }
        const int gt = bx * (NWAVES * 64) + tid, NGT = G * NWAVES * 64;
        for (size_t i = gt; i < (size_t)M * D / 8; i += NGT) { const f32x4 a = ((const f32x4*)x)[2 * i], b = ((const f32x4*)x)[2 * i + 1];
            v4u o; o.x = pg8::pk_bf16(a.x, a.y); o.y = pg8::pk_bf16(a.z, a.w); o.z = pg8::pk_bf16(b.x, b.y); o.w = pg8::pk_bf16(b.z, b.w); ((v4u*)XB)[i] = o; }
        for (int i = gt; i < SEQ * 24; i += NGT) { const int pos = i / 24, k = i % 24;
            if (k < 8) { const float ang = (float)pos * args.invD[k]; tabD[pos * 16 + k] = cosf(ang); tabD[pos * 16 + 8 + k] = sinf(ang); }
            else { const int kk = k - 8; const float ang = (float)pos * args.invM[kk]; tabM[pos * 32 + kk] = cosf(ang); tabM[pos * 32 + 16 + kk] = sinf(ang); } }
    }
    SEAM(0);
    if (IN(1) && !(SKIPMASK & (1 << 1))) { TIDS();
        unsigned char* ws = args.ws; float* tabD = (float*)(ws + WS_TABD); float* tabM = (float*)(ws + WS_TABM); float* kpart = (float*)(ws + WS_KPART); bf16* Wt_in = (bf16*)(ws + WS_WIN); bf16* XB = (bf16*)(ws + WS_XB); bf16* P = (bf16*)(ws + WS_P);

        pg8::Gemm g{XB, Wt_in, M, NPROJ, D, D}; pg8::StaticOrder S; S.init(M, NPROJ, G, bx);
        pg8::EpiProj E{P, tabD, tabM, kpart, 0.125f * LOG2E, 0.08838834764831845f * LOG2E};
        pg8::gemm_phase<pg8::EpiProj, pg8::StaticOrder, true, true>(lds, g, S, E);
    }
    SEAM(1);
    if (IN(2) && !(SKIPMASK & (1 << 2))) { TIDS();
        const float* lq1 = args.in[2]; const float* lk1 = args.in[3]; const float* lq2 = args.in[4]; const float* lk2 = args.in[5]; const float* subln_g = args.in[6]; unsigned char* ws = args.ws; unsigned* ctl = (unsigned*)(ws + WS_CTL); float* kpart = (float*)(ws + WS_KPART); bf16* P = (bf16*)(ws + WS_P); bf16* AO = (bf16*)(ws + WS_AO);

        float lam;
        { const float a = wave_sum(lq1[lane] * lk1[lane]), b = wave_sum(lq2[lane] * lk2[lane]); lam = expf(a) - expf(b) + 0.2f; }
        volatile LAS int* slot = (volatile LAS int*)(lds + att::OFF_SLOT);
        for (;;) {
            __syncthreads();
            if (tid == 0) *slot = (int)atomicAdd(ctl, 1u);
            __syncthreads();
            const int idx = *slot;
            if (idx >= 1536) break;
            const int gq = 15 - idx / 96, rem = idx % 96, type = rem >> 5, bh = rem & 31, b = bh >> 3, h = bh & 7;
            if (type == 0) {
#ifndef NO_MOBA
 att::moba_unit(b, h, gq, P, AO, kpart, lds, tid);
#endif
 }
            else
#ifndef NO_DIFF
 att::diff_unit(b, h, type == 1 ? 2 * gq + 1 : 2 * gq, P, AO, lam, subln_g, lds, tid);
#else
 ;
#endif
        }
    }
    SEAM(2);
    if (IN(3) && !(SKIPMASK & (1 << 3))) { TIDS();
        const float* x = args.in[0]; float* out = args.out; unsigned char* ws = args.ws; bf16* AO = (bf16*)(ws + WS_AO); bf16* Wt_out = (bf16*)(ws + WS_WOUT);

        pg8::Gemm g{AO, Wt_out, M, D, D, D}; pg8::StaticOrder S; S.init(M, D, G, bx);
        pg8::EpiResid E{x, out, D, ALPHA};
        pg8::gemm_phase<pg8::EpiResid, pg8::StaticOrder, true, true>(lds, g, S, E);
    }
    SEAM(3);
    if (IN(4) && !(SKIPMASK & (1 << 4))) { TIDS(); const float* ln1_g = args.in[8]; const float* ln1_b = args.in[9]; float* out = args.out; unsigned char* ws = args.ws; bf16* H1B = (bf16*)(ws + WS_H1B); ln_rows(out, H1B, ln1_g, ln1_b, gw, NGW, lane); }
    SEAM(4);
    if (IN(5) && !(SKIPMASK & (1 << 5))) { TIDS();
        unsigned char* ws = args.ws; bf16* H1B = (bf16*)(ws + WS_H1B); bf16* Wt_up = (bf16*)(ws + WS_WUP); bf16* U = (bf16*)(ws + WS_U);

        pg8::Gemm g{H1B, Wt_up, M, NUP, D, D}; pg8::StaticOrder S; S.init(M, NUP, G, bx);
        pg8::EpiPlainBf16 E{U, NUP};
        pg8::gemm_phase<pg8::EpiPlainBf16, pg8::StaticOrder, true, true>(lds, g, S, E);
    }
    SEAM(5);
    if (IN(6) && !(SKIPMASK & (1 << 6))) { TIDS();
        const float* conv_w = args.in[11]; const float* conv_b = args.in[12]; unsigned char* ws = args.ws; bf16* U = (bf16*)(ws + WS_U);

        const int gt = bx * (NWAVES * 64) + tid, NGT = G * NWAVES * 64;
        constexpr int NFC = FF / 8, NRC = M / 16;
        for (int it = gt; it < NFC * NRC; it += NGT) {
            const int fc = it % NFC, rc = it / NFC, f0 = 8 * fc, t0 = 16 * rc;
            float w0[8], w1[8], w2[8], cb[8], gm2[8], gm1[8];
#pragma unroll
            for (int e = 0; e < 8; ++e) { w0[e] = conv_w[f0 + e]; w1[e] = conv_w[FF + f0 + e]; w2[e] = conv_w[2 * FF + f0 + e]; cb[e] = conv_b[f0 + e]; gm2[e] = 0.f; gm1[e] = 0.f; }
            if ((t0 & (SEQ - 1)) != 0) {
                const v4u a = *(const v4u*)(U + (size_t)(t0 - 2) * NUP + f0), b = *(const v4u*)(U + (size_t)(t0 - 1) * NUP + f0);
#pragma unroll
                for (int e = 0; e < 4; ++e) { gm2[2 * e] = __uint_as_float(a[e] << 16); gm2[2 * e + 1] = __uint_as_float(a[e] & 0xffff0000u); gm1[2 * e] = __uint_as_float(b[e] << 16); gm1[2 * e + 1] = __uint_as_float(b[e] & 0xffff0000u); }
            }
            for (int r = 0; r < 16; ++r) {
                bf16* up = U + (size_t)(t0 + r) * NUP + f0;
                const v4u gv = *(const v4u*)up, vv = *(const v4u*)(up + FF);
                float gc[8], av[8];
#pragma unroll
                for (int e = 0; e < 4; ++e) { gc[2 * e] = __uint_as_float(gv[e] << 16); gc[2 * e + 1] = __uint_as_float(gv[e] & 0xffff0000u); av[2 * e] = __uint_as_float(vv[e] << 16); av[2 * e + 1] = __uint_as_float(vv[e] & 0xffff0000u); }
#pragma unroll
                for (int e = 0; e < 8; ++e) { const float c = cb[e] + w0[e] * gm2[e] + w1[e] * gm1[e] + w2[e] * gc[e]; gm2[e] = gm1[e]; gm1[e] = gc[e];
                    av[e] = av[e] * c / (1.f + __expf(-c)); }
                v4u o; o.x = pg8::pk_bf16(av[0], av[1]); o.y = pg8::pk_bf16(av[2], av[3]); o.z = pg8::pk_bf16(av[4], av[5]); o.w = pg8::pk_bf16(av[6], av[7]);
                *(v4u*)(up + FF) = o;
            }
        }
    }
    SEAM(6);
    if (IN(7) && !(SKIPMASK & (1 << 7))) { TIDS();
        float* out = args.out; unsigned char* ws = args.ws; bf16* U = (bf16*)(ws + WS_U); bf16* Wt_down = (bf16*)(ws + WS_WDOWN);

        pg8::Gemm g{U + FF, Wt_down, M, D, FF, NUP}; pg8::StaticOrder S; S.init(M, D, G, bx);
        pg8::EpiResid E{out, out, D, ALPHA};
        pg8::gemm_phase<pg8::EpiResid, pg8::StaticOrder, true, true>(lds, g, S, E);
    }
    SEAM(7);
    if (IN(8) && !(SKIPMASK & (1 << 8))) { TIDS(); const float* ln2_g = args.in[14]; const float* ln2_b = args.in[15]; float* out = args.out; ln_rows(out, nullptr, ln2_g, ln2_b, gw, NGW, lane); }
#undef IN
#undef SEAM
}

extern "C" void kernel_launch(void* const* d_in, const int* in_sizes, int n_in, void* d_out, int out_size, void* d_ws, size_t ws_size, hipStream_t stream) {
    static int grid = 0;
    if (grid == 0) {
        if (n_in != 16 || in_sizes[0] != M * D || out_size != M * D || ws_size < WS_END) { fprintf(stderr, "kernel_launch: unexpected shapes (n_in %d, in0 %d, out %d, ws %zu); nothing launched\n", n_in, n_in > 0 ? in_sizes[0] : -1, out_size, ws_size); grid = -1; return; }
        int dev = 0, cus = 0, per_cu = 0;
        if (hipGetDevice(&dev) != hipSuccess || hipDeviceGetAttribute(&cus, hipDeviceAttributeMultiprocessorCount, dev) != hipSuccess) { grid = -1; return; }
        if (hipFuncSetAttribute((const void*)mega, hipFuncAttributeMaxDynamicSharedMemorySize, LDS_BYTES) != hipSuccess) { fprintf(stderr, "kernel_launch: hipFuncSetAttribute failed\n"); grid = -1; return; }
        if (hipOccupancyMaxActiveBlocksPerMultiprocessor(&per_cu, (const void*)mega, NWAVES * 64, LDS_BYTES) != hipSuccess || per_cu < 1) { fprintf(stderr, "kernel_launch: occupancy query failed (%d)\n", per_cu); (void)hipGetLastError(); per_cu = 1; }
        grid = cus * per_cu;
    }
    if (grid < 0) return;
    Args a{};
    for (int i = 0; i < 16; ++i) a.in[i] = (const float*)d_in[i];
    a.out = (float*)d_out; a.ws = (unsigned char*)d_ws;
    for (int i = 0; i < 8; ++i) a.invD[i] = (float)(1.0 / pow(500000.0, (double)(2 * i) / 16.0));
    for (int i = 0; i < 16; ++i) a.invM[i] = (float)(1.0 / pow(500000.0, (double)(2 * i) / 32.0));
    if (N_LAUNCHES == 1) {
        a.ph_lo = 0; a.ph_hi = NPH;
        void* kargs[] = {&a};
        hipError_t e = hipLaunchCooperativeKernel((const void*)mega, dim3(grid), dim3(NWAVES * 64), kargs, LDS_BYTES, stream);
        if (e != hipSuccess) fprintf(stderr, "cooperative launch failed: %s (grid %d)\n", hipGetErrorString(e), grid);
    } else {
        for (int ph = 0; ph < NPH; ++ph) { a.ph_lo = ph; a.ph_hi = ph + 1; hipLaunchKernelGGL(mega, dim3(grid), dim3(NWAVES * 64), LDS_BYTES, stream, a); }
    }
}
```

```cpp
#include <hip/hip_runtime.h>
#include <hip/hip_cooperative_groups.h>
#include <cstdio>
#include <cstdint>
#include <cmath>
namespace cg = cooperative_groups;
#ifndef MK_N_LAUNCHES
#define MK_N_LAUNCHES 1
#endif
namespace pg8 {
#define PG8_LAS __attribute__((address_space(3)))
typedef unsigned short bf16_t;
typedef short bf16x8 __attribute__((ext_vector_type(8)));
typedef float f32x4 __attribute__((ext_vector_type(4)));
typedef unsigned u32x4 __attribute__((ext_vector_type(4)));
constexpr int BM = 256, BK = 64, HALF = 128, HTB = HALF * BK * 2  , STAGE_BYTES = 8 * HTB, NXCD = 8, WGM = 8;

__host__ __device__ __forceinline__ int lds_byte(int r, int c) { const int st = (r >> 4) * 2 + (c >> 5), rr = r & 15, cc = c & 31, ob = rr * 64 + cc * 2; return st * 1024 + (ob ^ (((ob >> 9) & 1) << 5)); }
__host__ __device__ __forceinline__ void stage_rc(int b, int& R, int& C) { const int st = b / 1024, sb = b % 1024, swz = sb ^ (((sb >> 9) & 1) << 5); R = (st >> 1) * 16 + swz / 64; C = (st & 1) * 32 + (swz % 64) / 2; }
__host__ __device__ __forceinline__ int perm32(int rho) { const int n = rho >> 4, i = rho & 15; return 8 * (i >> 2) + 4 * n + (i & 3); }

struct Unit { int pm, pn; };
struct Gemm { const bf16_t* A; const bf16_t* Bt; int M, N, K, lda; };

struct StaticOrder {
    int nM, nN, nwg, G, c;
    __host__ __device__ void init(int M, int N, int G_, int c_) { nM = M / BM; nN = N / BM; nwg = nM * nN; G = G_; c = c_; }
    __host__ __device__ bool next(int i, Unit& u) const {
        const long L = (long)i * G + c; if (L >= nwg) return false;
        int wgid = (int)L; { const int q = nwg / NXCD, r = nwg % NXCD, xcd = wgid % NXCD, off = wgid / NXCD; wgid = (xcd < r ? xcd * (q + 1) : r * (q + 1) + (xcd - r) * q) + off; }
        const int nig = WGM * nN, gid = wgid / nig, fm = gid * WGM, gsz = (nM - fm) < WGM ? (nM - fm) : WGM;
        u.pm = fm + ((wgid % nig) % gsz); u.pn = (wgid % nig) / gsz; return true;
    }
    __device__ __forceinline__ void a_ready(const Unit&) const {}
    __device__ __forceinline__ void done(const Unit&) const {}
};

__device__ __forceinline__ unsigned cvt_pk_bf16(float lo, float hi) { unsigned r; asm volatile("v_cvt_pk_bf16_f32 %0, %1, %2" : "=v"(r) : "v"(lo), "v"(hi)); return r; }
typedef float f32x2 __attribute__((ext_vector_type(2)));
typedef float f32x2 __attribute__((ext_vector_type(2)));
typedef __bf16 bf16x2_t __attribute__((ext_vector_type(2)));
__device__ __forceinline__ unsigned pk_bf16(float lo, float hi) { f32x2 v = {lo, hi}; bf16x2_t b = __builtin_convertvector(v, bf16x2_t); return __builtin_bit_cast(unsigned, b); }

struct EpiPlainBf16 {
    static constexpr bool PERM = true, AFTER_DRAIN = false;
    bf16_t* O; int ldc;
    __device__ __forceinline__ void operator()(const f32x4 (&acc)[2][2][4][2], const Unit& u, int wr, int wc, int fr, int fq) const {
        const int row0 = u.pm * BM + wr * 64 + fr, col0 = u.pn * BM + wc * 32 + 8 * fq;
#pragma unroll
        for (int ai = 0; ai < 2; ++ai)
#pragma unroll
            for (int m = 0; m < 4; ++m) { bf16_t* rowp = O + (size_t)(row0 + ai * HALF + m * 16) * ldc + col0;
#pragma unroll
                for (int bj = 0; bj < 2; ++bj) { const f32x4 v0 = acc[ai][bj][m][0], v1 = acc[ai][bj][m][1];
                    u32x4 w; w.x = pk_bf16(v0[0], v0[1]); w.y = pk_bf16(v0[2], v0[3]); w.z = pk_bf16(v1[0], v1[1]); w.w = pk_bf16(v1[2], v1[3]);
                    *(u32x4*)(rowp + bj * HALF) = w; } }
    }
};

struct EpiProj {
    static constexpr bool PERM = true, AFTER_DRAIN = false;
    bf16_t* O; const float* tabD; const float* tabM; float* kpart; float qscale_d, qscale_m;
    __device__ __forceinline__ void operator()(const f32x4 (&acc)[2][2][4][2], const Unit& u, int wr, int wc, int fr, int fq) const {
        const int region = u.pn >> 2;
        const int row0 = u.pm * BM + wr * 64 + fr, col0 = u.pn * BM + wc * 32 + 8 * fq;
        const bool ropeD = (region <= 1) && ((wc & 1) == 0);
        const bool ropeM = (region == 3 || region == 4) && (wc == 0);
        const float sc = region == 0 ? qscale_d : (region == 3 ? qscale_m : 1.f);
        f32x4 ks[2][2];
#pragma unroll
        for (int bj = 0; bj < 2; ++bj) { ks[bj][0] = (f32x4){0.f, 0.f, 0.f, 0.f}; ks[bj][1] = (f32x4){0.f, 0.f, 0.f, 0.f}; }
#pragma unroll
        for (int ai = 0; ai < 2; ++ai)
#pragma unroll
            for (int m = 0; m < 4; ++m) {
                const int r = row0 + ai * HALF + m * 16, pos = r & 4095;
                f32x4 c0 = {1.f, 1.f, 1.f, 1.f}, c1 = c0, s0 = {0.f, 0.f, 0.f, 0.f}, s1 = s0;
                if (ropeD) { const float* t = tabD + pos * 16; c0 = *(const f32x4*)t; c1 = *(const f32x4*)(t + 4); s0 = *(const f32x4*)(t + 8); s1 = *(const f32x4*)(t + 12); }
                else if (ropeM) { const float* t = tabM + pos * 32 + 8 * (fq & 1); c0 = *(const f32x4*)t; c1 = *(const f32x4*)(t + 4); s0 = *(const f32x4*)(t + 16); s1 = *(const f32x4*)(t + 20); }
                bf16_t* rowp = O + (size_t)r * 6144 + col0;
#pragma unroll
                for (int bj = 0; bj < 2; ++bj) {
                    f32x4 v0 = acc[ai][bj][m][0], v1 = acc[ai][bj][m][1];
                    if (ropeD) {
                        f32x4 p0, p1;
#pragma unroll
                        for (int e = 0; e < 4; ++e) { p0[e] = __shfl_xor(v0[e], 16); p1[e] = __shfl_xor(v1[e], 16); }
                        const f32x4 sg0 = (fq == 0) ? -s0 : s0, sg1 = (fq == 0) ? -s1 : s1;
                        const f32x4 n0 = v0 * c0 + p0 * sg0, n1 = v1 * c1 + p1 * sg1;
                        if (fq < 2) { v0 = n0; v1 = n1; }
                    } else if (ropeM) {
                        f32x4 p0, p1;
#pragma unroll
                        for (int e = 0; e < 4; ++e) { p0[e] = __shfl_xor(v0[e], 32); p1[e] = __shfl_xor(v1[e], 32); }
                        const f32x4 sg0 = (fq < 2) ? -s0 : s0, sg1 = (fq < 2) ? -s1 : s1;
                        v0 = v0 * c0 + p0 * sg0; v1 = v1 * c1 + p1 * sg1;
                    }
                    v0 = v0 * sc; v1 = v1 * sc;
                    ks[bj][0] += v0; ks[bj][1] += v1;
                    u32x4 w; w.x = pk_bf16(v0[0], v0[1]); w.y = pk_bf16(v0[2], v0[3]); w.z = pk_bf16(v1[0], v1[1]); w.w = pk_bf16(v1[2], v1[3]);
                    *(u32x4*)(rowp + bj * HALF) = w;
                }
            }
        if (region == 4) {
#pragma unroll
            for (int bj = 0; bj < 2; ++bj)
#pragma unroll
                for (int n = 0; n < 2; ++n)
#pragma unroll
                    for (int e = 0; e < 4; ++e) { float v = ks[bj][n][e]; v += __shfl_xor(v, 1); v += __shfl_xor(v, 2); v += __shfl_xor(v, 4); v += __shfl_xor(v, 8); ks[bj][n][e] = v; }
            if (fr == 0) {
                float* kp = kpart + (size_t)(u.pm * 2 + wr) * 1024 + (col0 - 4096);
#pragma unroll
                for (int bj = 0; bj < 2; ++bj) { *(f32x4*)(kp + bj * HALF) = ks[bj][0]; *(f32x4*)(kp + bj * HALF + 4) = ks[bj][1]; }
            }
        }
    }
};

struct EpiResid {
    static constexpr bool PERM = false, AFTER_DRAIN = false;
    const float* base; float* out; int ldc; float alpha;
    __device__ __forceinline__ void operator()(const f32x4 (&acc)[2][2][4][2], const Unit& u, int wr, int wc, int fr, int fq) const {
        const int col0 = u.pn * BM + wc * 32 + 4 * fq;
#pragma unroll
        for (int ai = 0; ai < 2; ++ai)
#pragma unroll
            for (int m = 0; m < 4; ++m) { const size_t off = (size_t)(u.pm * BM + ai * HALF + wr * 64 + m * 16 + fr) * ldc + col0;
#pragma unroll
                for (int bj = 0; bj < 2; ++bj)
#pragma unroll
                    for (int n = 0; n < 2; ++n) { const f32x4 bs = *(const f32x4*)(base + off + bj * HALF + n * 16); *(f32x4*)(out + off + bj * HALF + n * 16) = bs * alpha + acc[ai][bj][m][n]; } }
    }
};

typedef unsigned u32x2 __attribute__((ext_vector_type(2)));
struct EpiConvGate {
    static constexpr bool PERM = true, AFTER_DRAIN = false;
    bf16_t* ACT; const float* conv_w; const float* conv_b; float* HG; float* FX; PG8_LAS float* bnd;
    __device__ __forceinline__ void operator()(const f32x4 (&acc)[2][2][4][2], const Unit& u, int wr, int wc, int fr, int fq) const {
        constexpr int F = 5632;
        const int lane = fr + 16 * fq;
        const int cl = wc * 32 + 8 * fq;
        const int f0 = u.pn * 128 + cl;
        if (fr >= 14) {
#pragma unroll
            for (int ai = 0; ai < 2; ++ai) { PG8_LAS float* bp = bnd + ((2 * ai + wr) * 2 + (fr - 14)) * 128 + cl;
                *(PG8_LAS f32x4*)bp = acc[ai][0][3][0]; *(PG8_LAS f32x4*)(bp + 4) = acc[ai][0][3][1]; }
            if (wr == 1) { float* hp = HG + ((size_t)u.pm * 2 + (fr - 14)) * F + f0; *(f32x4*)hp = acc[1][0][3][0]; *(f32x4*)(hp + 4) = acc[1][0][3][1]; }
        }
        asm volatile("s_waitcnt lgkmcnt(0)\n\ts_barrier" ::: "memory");
        const int s1 = (lane & 48) | ((fr - 1) & 15), s2 = (lane & 48) | ((fr - 2) & 15);
        const bool seq_start = (u.pm & 15) == 0;
#pragma unroll
        for (int n = 0; n < 2; ++n) {
            const f32x4 w0 = *(const f32x4*)(conv_w + f0 + 4 * n), w1 = *(const f32x4*)(conv_w + F + f0 + 4 * n), w2 = *(const f32x4*)(conv_w + 2 * F + f0 + 4 * n), cb = *(const f32x4*)(conv_b + f0 + 4 * n);
#pragma unroll
            for (int ai = 0; ai < 2; ++ai) {
                __builtin_amdgcn_sched_barrier(0);
                const int ci = 2 * ai + wr;
                f32x4 bm1 = {0.f, 0.f, 0.f, 0.f}, bm2 = bm1;
                if (ci > 0) { const PG8_LAS float* bp = bnd + ((ci - 1) * 2) * 128 + cl + 4 * n; bm2 = *(const PG8_LAS f32x4*)bp; bm1 = *(const PG8_LAS f32x4*)(bp + 128); }
                f32x4 pa = bm1, pb = (fr == 0) ? bm2 : bm1;
#pragma unroll
                for (int m = 0; m < 4; ++m) {
                    const f32x4 g = acc[ai][0][m][n], vv = acc[ai][1][m][n];
                    f32x4 A, B;
#pragma unroll
                    for (int e = 0; e < 4; ++e) { A[e] = __shfl(g[e], s1); B[e] = __shfl(g[e], s2); }
                    const f32x4 p1 = (fr == 0) ? pa : A, p2 = (fr < 2) ? pb : B;
                    pa = A; pb = B;
                    const f32x4 gc = cb + w0 * p2 + w1 * p1 + w2 * g;
                    if (ai == 0 && m == 0 && wr == 0 && fr < 2 && !seq_start) { float* fp = FX + (((size_t)u.pm * 2 + fr) * 2) * F + f0 + 4 * n; *(f32x4*)fp = gc; *(f32x4*)(fp + F) = vv; }
                    f32x4 a;
#pragma unroll
                    for (int e = 0; e < 4; ++e) a[e] = vv[e] * gc[e] * __builtin_amdgcn_rcpf(1.f + __builtin_amdgcn_exp2f(-1.4426950408889634f * gc[e]));
                    u32x2 w; w.x = pk_bf16(a[0], a[1]); w.y = pk_bf16(a[2], a[3]);
                    *(u32x2*)(ACT + (size_t)(u.pm * BM + ai * HALF + wr * 64 + m * 16 + fr) * F + f0 + 4 * n) = w;
                }
            }
        }
    }
};

template <class Epi, class Sched, bool ALIGN_EPI = false, bool SP2 = false>
__device__ __forceinline__ void gemm_phase(PG8_LAS unsigned char* lds, const Gemm g, const Sched& S, const Epi& E) {
    const int tid = threadIdx.x, wid = __builtin_amdgcn_readfirstlane(tid >> 6), lane = tid & 63, wr = wid >> 2, wc = wid & 3, fr = lane & 15, fq = lane >> 4;
    const int K = g.K, nt = K / BK;
    unsigned voffA[2], voffB[2];
#pragma unroll
    for (int i = 0; i < 2; ++i) { int R, C; stage_rc(tid * 16 + i * 8192, R, C); const int Rb = Epi::PERM ? ((R & ~31) + perm32(R & 31)) : R;
        voffA[i] = (unsigned)(R * g.lda + C) * 2u; voffB[i] = (unsigned)(Rb * K + C) * 2u; }
    const size_t kstep = (size_t)(BK * 2);
    const size_t hstepB = (size_t)HALF * K * 2, hstepA = (size_t)HALF * g.lda * 2;
    const size_t tstepB = 2 * hstepB, tstepA = 2 * hstepA;
    const unsigned ldsw = (unsigned)wid * 1024u;
    const int aoff = lds_byte(wr * 64 + fr, fq * 8), boff = lds_byte(wc * 32 + fr, fq * 8);
#define PG8_SA(b, h) (((b) * 2 + (h)) * HTB)
#define PG8_SB(b, h) ((4 + (b) * 2 + (h)) * HTB)
#define PG8_STAGE(bufoff, gbase, voff) do { _Pragma("unroll") for (int _i = 0; _i < 2; ++_i) \
        __builtin_amdgcn_global_load_lds((const unsigned*)((const char*)(gbase) + (voff)[_i]), (PG8_LAS unsigned*)(lds + (bufoff) + ldsw + _i * 8192), 16, 0, 0); } while (0)
#define PG8_LDA(dst, b, h) do { _Pragma("unroll") for (int m = 0; m < 4; ++m) _Pragma("unroll") for (int k = 0; k < 2; ++k) dst[m][k] = *(const PG8_LAS bf16x8*)(lds + PG8_SA(b, h) + aoff + m * 2048 + k * 1024); } while (0)
#define PG8_LDB(dst, b, h) do { _Pragma("unroll") for (int n = 0; n < 2; ++n) _Pragma("unroll") for (int k = 0; k < 2; ++k) dst[n][k] = *(const PG8_LAS bf16x8*)(lds + PG8_SB(b, h) + boff + n * 2048 + k * 1024); } while (0)
#define PG8_MMA(ai, bj, At, Bt) do { __builtin_amdgcn_s_setprio(1); _Pragma("unroll") for (int m = 0; m < 4; ++m) _Pragma("unroll") for (int n = 0; n < 2; ++n) _Pragma("unroll") for (int k = 0; k < 2; ++k) \
        acc[ai][bj][m][n] = __builtin_amdgcn_mfma_f32_16x16x32_bf16(Bt[n][k], At[m][k], acc[ai][bj][m][n], 0, 0, 0); __builtin_amdgcn_s_setprio(0); } while (0)
#define PG8_WAIT_V(n) asm volatile("s_waitcnt vmcnt(" #n ")" ::: "memory")
#define PG8_WAIT_L(n) asm volatile("s_waitcnt lgkmcnt(" #n ")" ::: "memory")
#define PG8_BAR __builtin_amdgcn_s_barrier()
#define PG8_SCHED __builtin_amdgcn_sched_barrier(0)
    Unit cur, nxt; int ui = 0;
    if (!S.next(0, cur)) return;
    f32x4 acc[2][2][4][2];
#pragma unroll
    for (int a = 0; a < 2; ++a)
#pragma unroll
        for (int b = 0; b < 2; ++b)
#pragma unroll
            for (int m = 0; m < 4; ++m)
#pragma unroll
                for (int n = 0; n < 2; ++n) acc[a][b][m][n] = (f32x4){0.f, 0.f, 0.f, 0.f};
    bf16x8 At[4][2], B0[2][2], B1[2][2];
    const char* cA = (const char*)g.A + (size_t)cur.pm * tstepA; const char* cB = (const char*)g.Bt + (size_t)cur.pn * tstepB;
    S.a_ready(cur);
    if constexpr (SP2) {
        PG8_STAGE(PG8_SB(0, 0), cB, voffB); PG8_STAGE(PG8_SB(0, 1), cB + hstepB, voffB); PG8_STAGE(PG8_SA(0, 0), cA, voffA); PG8_STAGE(PG8_SA(0, 1), cA + hstepA, voffA);
        if (wr == 1) PG8_BAR;
        PG8_WAIT_V(2); PG8_BAR;
        PG8_STAGE(PG8_SB(1, 0), cB + kstep, voffB); PG8_STAGE(PG8_SA(1, 0), cA + kstep, voffA); PG8_STAGE(PG8_SB(1, 1), cB + hstepB + kstep, voffB);
        PG8_WAIT_V(6); PG8_BAR;
    } else {
        PG8_STAGE(PG8_SB(0, 0), cB, voffB); PG8_STAGE(PG8_SA(0, 0), cA, voffA); PG8_STAGE(PG8_SB(0, 1), cB + hstepB, voffB); PG8_STAGE(PG8_SA(0, 1), cA + hstepA, voffA);
        if (wr == 1) PG8_BAR;
        PG8_WAIT_V(4); PG8_BAR;
        PG8_STAGE(PG8_SB(1, 0), cB + kstep, voffB); PG8_STAGE(PG8_SA(1, 0), cA + kstep, voffA); PG8_STAGE(PG8_SB(1, 1), cB + hstepB + kstep, voffB);
        PG8_WAIT_V(6); PG8_BAR;
    }
    for (;;) {
        const bool has_next = S.next(ui + 1, nxt);
        const char* nA = has_next ? (const char*)g.A + (size_t)nxt.pm * tstepA : cA; const char* nB = has_next ? (const char*)g.Bt + (size_t)nxt.pn * tstepB : cB;
        for (int t = 0; t < nt; t += 2) {
            const bool last = (t == nt - 2);
            const char* a1 = cA + (size_t)(t + 1) * kstep;
            const char* a2 = last ? nA : cA + (size_t)(t + 2) * kstep; const char* b2 = last ? nB : cB + (size_t)(t + 2) * kstep;
            const char* a3 = a2 + kstep; const char* b3 = b2 + kstep;
            if (last && has_next) S.a_ready(nxt);
            if constexpr (SP2) {
            PG8_LDB(B0, 0, 0); PG8_LDB(B1, 0, 1); PG8_SCHED; PG8_LDA(At, 0, 0); PG8_STAGE(PG8_SA(1, 1), a1 + hstepA, voffA);
            PG8_WAIT_V(8); PG8_WAIT_L(0); PG8_BAR; PG8_MMA(0, 0, At, B0); PG8_MMA(0, 1, At, B1); PG8_BAR; PG8_SCHED;
            PG8_LDA(At, 0, 1); PG8_STAGE(PG8_SB(0, 0), b2, voffB); PG8_STAGE(PG8_SB(0, 1), b2 + hstepB, voffB); PG8_STAGE(PG8_SA(0, 0), a2, voffA);
            PG8_WAIT_V(8); PG8_WAIT_L(0); PG8_BAR; PG8_MMA(1, 0, At, B0); PG8_MMA(1, 1, At, B1); PG8_BAR; PG8_SCHED;
            PG8_LDB(B0, 1, 0); PG8_LDB(B1, 1, 1); PG8_SCHED; PG8_LDA(At, 1, 0); PG8_STAGE(PG8_SA(0, 1), a2 + hstepA, voffA);
            PG8_WAIT_V(8); PG8_WAIT_L(0); PG8_BAR; PG8_MMA(0, 0, At, B0); PG8_MMA(0, 1, At, B1); PG8_BAR; PG8_SCHED;
            PG8_LDA(At, 1, 1); PG8_STAGE(PG8_SB(1, 0), b3, voffB); PG8_STAGE(PG8_SB(1, 1), b3 + hstepB, voffB); PG8_STAGE(PG8_SA(1, 0), a3, voffA);
            PG8_WAIT_V(8); PG8_WAIT_L(0); PG8_BAR; PG8_MMA(1, 0, At, B0); PG8_MMA(1, 1, At, B1); PG8_BAR; PG8_SCHED;
            } else {
            PG8_LDB(B0, 0, 0); PG8_SCHED; PG8_LDA(At, 0, 0); PG8_STAGE(PG8_SA(1, 1), a1 + hstepA, voffA);
            PG8_WAIT_L(8); PG8_BAR; PG8_WAIT_L(0); PG8_MMA(0, 0, At, B0); PG8_BAR; PG8_SCHED;
            PG8_LDB(B1, 0, 1); PG8_STAGE(PG8_SB(0, 0), b2, voffB);
            PG8_BAR; PG8_WAIT_L(0); PG8_MMA(0, 1, At, B1); PG8_BAR;
            PG8_LDA(At, 0, 1); PG8_STAGE(PG8_SA(0, 0), a2, voffA);
            PG8_BAR; PG8_WAIT_L(0); PG8_MMA(1, 0, At, B0); PG8_BAR; PG8_SCHED;
            PG8_STAGE(PG8_SB(0, 1), b2 + hstepB, voffB);
            PG8_WAIT_V(6); PG8_BAR; PG8_MMA(1, 1, At, B1); PG8_BAR;
            PG8_LDB(B0, 1, 0); PG8_SCHED; PG8_LDA(At, 1, 0); PG8_STAGE(PG8_SA(0, 1), a2 + hstepA, voffA);
            PG8_WAIT_L(8); PG8_BAR; PG8_WAIT_L(0); PG8_MMA(0, 0, At, B0); PG8_BAR; PG8_SCHED;
            PG8_LDB(B1, 1, 1); PG8_STAGE(PG8_SB(1, 0), b3, voffB);
            PG8_BAR; PG8_WAIT_L(0); PG8_MMA(0, 1, At, B1); PG8_BAR;
            PG8_LDA(At, 1, 1); PG8_STAGE(PG8_SA(1, 0), a3, voffA);
            PG8_BAR; PG8_WAIT_L(0); PG8_MMA(1, 0, At, B0); PG8_BAR; PG8_SCHED;
            PG8_STAGE(PG8_SB(1, 1), b3 + hstepB, voffB);
            PG8_WAIT_V(6); PG8_BAR; PG8_MMA(1, 1, At, B1); PG8_BAR;
            }
        }
        if constexpr (ALIGN_EPI) { if (wr == 0) PG8_BAR; }
        if constexpr (!Epi::AFTER_DRAIN) { E(acc, cur, wr, wc, fr, fq); S.done(cur); }
        if (!has_next) break;
#pragma unroll
        for (int a = 0; a < 2; ++a)
#pragma unroll
            for (int b = 0; b < 2; ++b)
#pragma unroll
                for (int m = 0; m < 4; ++m)
#pragma unroll
                    for (int n = 0; n < 2; ++n) acc[a][b][m][n] = (f32x4){0.f, 0.f, 0.f, 0.f};
        cur = nxt; cA = nA; cB = nB; ++ui;
        if constexpr (ALIGN_EPI) { if (wr == 1) PG8_BAR; }
    }
    PG8_WAIT_V(0);
    if constexpr (!ALIGN_EPI) { if (wr == 0) PG8_BAR; }
    PG8_BAR;
    if constexpr (Epi::AFTER_DRAIN) { E.fused(acc, cur, wr, wc, fr, fq, lds, wid, lane); S.done(cur); }
#undef PG8_SA
#undef PG8_SB
#undef PG8_STAGE
#undef PG8_LDA
#undef PG8_LDB
#undef PG8_MMA
#undef PG8_WAIT_V
#undef PG8_WAIT_L
#undef PG8_BAR
#undef PG8_SCHED
}
}
namespace att {
#define LAS __attribute__((address_space(3)))
typedef unsigned short bf16_t;
typedef short bf16x8 __attribute__((ext_vector_type(8)));
typedef short s16x4 __attribute__((ext_vector_type(4)));
typedef float f32x4 __attribute__((ext_vector_type(4)));
typedef float f32x16 __attribute__((ext_vector_type(16)));
typedef unsigned u32x4 __attribute__((ext_vector_type(4)));
typedef unsigned u32x2 __attribute__((ext_vector_type(2)));
constexpr int PITCH = 6144;
constexpr int AOP = 2048;
constexpr int OFF_K = 0, OFF_V = 32768, OFF_KM = 65536, OFF_SLOT = 65536 + 8192;
constexpr float NEG = -1.0e30f;
__device__ __forceinline__ int toff(int row, int ch) { return 2048 * (row >> 3) + 512 * (ch >> 2) + 64 * (row & 7) + 16 * ((ch & 3) ^ ((row >> 2) & 3)); }
__device__ __forceinline__ float xsum32(float v) { auto rr = __builtin_amdgcn_permlane32_swap(__float_as_uint(v), __float_as_uint(v), false, false); return __uint_as_float(rr[0]) + __uint_as_float(rr[1]); }
__device__ __forceinline__ float xmax32(float v) { auto rr = __builtin_amdgcn_permlane32_swap(__float_as_uint(v), __float_as_uint(v), false, false); return fmaxf(__uint_as_float(rr[0]), __uint_as_float(rr[1])); }
__device__ __forceinline__ float bf2f(short x) { return __uint_as_float(((unsigned)(unsigned short)x) << 16); }
__device__ __forceinline__ s16x4 vtr(LAS const unsigned char* p) { typedef short v4i16_t __attribute__((ext_vector_type(4))); return __builtin_bit_cast(s16x4, __builtin_amdgcn_ds_read_tr16_b64_v4i16((LAS v4i16_t*)p)); }

struct TileRegs { u32x4 k0, k1, v0, v1; };
__device__ __forceinline__ void tile_load(TileRegs& R, const bf16_t* Kg, const bf16_t* Vg, int tid) {
    const int r0 = tid >> 4, ch = tid & 15;
    R.k0 = *(const u32x4*)(Kg + (size_t)r0 * PITCH + 8 * ch); R.k1 = *(const u32x4*)(Kg + (size_t)(r0 + 32) * PITCH + 8 * ch);
    R.v0 = *(const u32x4*)(Vg + (size_t)r0 * PITCH + 8 * ch); R.v1 = *(const u32x4*)(Vg + (size_t)(r0 + 32) * PITCH + 8 * ch);
}
__device__ __forceinline__ void tile_store(const TileRegs& R, LAS unsigned char* kb, LAS unsigned char* vb, int tid) {
    const int r0 = tid >> 4, ch = tid & 15, o0 = toff(r0, ch);
    *(LAS u32x4*)(kb + o0) = R.k0; *(LAS u32x4*)(kb + o0 + 8192) = R.k1;
    *(LAS u32x4*)(vb + o0) = R.v0; *(LAS u32x4*)(vb + o0 + 8192) = R.v1;
}

template <int NS>
__device__ __forceinline__ void tile_compute(f32x16 (&o)[4], float& m, float& l, const bf16x8 (&qf)[NS], LAS const unsigned char* kb, LAS const unsigned char* vb,
                                             int kch0, int lane, bool causal, int qd, bool lane_sel) {
    const int l32 = lane & 31, hi = lane >> 5;
    const int kx = (l32 >> 2) & 3;
    LAS const unsigned char* kbase0 = kb + 2048 * (l32 >> 3) + 64 * (l32 & 7) + 512 * (kch0 >> 2) + 16 * (hi ^ kx);
    LAS const unsigned char* kbase1 = kb + 2048 * (l32 >> 3) + 64 * (l32 & 7) + 512 * (kch0 >> 2) + 16 * ((2 + hi) ^ kx);
    f32x16 st[2];
#pragma unroll
    for (int b = 0; b < 2; ++b) {
#pragma unroll
        for (int r = 0; r < 16; ++r) st[b][r] = 0.f;
#pragma unroll
        for (int s = 0; s < NS; ++s) {
            const bf16x8 kf = *(LAS const bf16x8*)(((s & 1) ? kbase1 : kbase0) + 8192 * b + 512 * (s >> 1));
            st[b] = __builtin_amdgcn_mfma_f32_32x32x16_bf16(kf, qf[s], st[b], 0, 0, 0);
        }
        __builtin_amdgcn_sched_barrier(0);
    }
    if (causal) {
#pragma unroll
        for (int b = 0; b < 2; ++b)
#pragma unroll
            for (int r = 0; r < 16; ++r) { const int key = 32 * b + (r & 3) + 8 * (r >> 2) + 4 * hi; if (key > qd) st[b][r] = NEG; }
    }
#pragma unroll
    for (int b = 0; b < 2; ++b)
#pragma unroll
        for (int r = 0; r < 16; ++r) st[b][r] = lane_sel ? st[b][r] : NEG;
    float rmax = st[0][0];
#pragma unroll
    for (int b = 0; b < 2; ++b)
#pragma unroll
        for (int r = 0; r < 16; ++r) rmax = fmaxf(rmax, st[b][r]);
    rmax = xmax32(rmax);
    const float mn = fmaxf(m, rmax);
    const float al = __builtin_amdgcn_exp2f(m - mn);
    m = mn;
    float sum = 0.f;
#pragma unroll
    for (int b = 0; b < 2; ++b)
#pragma unroll
        for (int r = 0; r < 16; ++r) { const float p = __builtin_amdgcn_exp2f(st[b][r] - mn); st[b][r] = p; sum += p; }
    l = l * al + sum;
#pragma unroll
    for (int d = 0; d < 4; ++d) o[d] = o[d] * al;
    bf16x8 pf[2][2];
#pragma unroll
    for (int b = 0; b < 2; ++b)
#pragma unroll
        for (int j = 0; j < 2; ++j) { u32x4 w; w.x = pg8::pk_bf16(st[b][8 * j + 0], st[b][8 * j + 1]); w.y = pg8::pk_bf16(st[b][8 * j + 2], st[b][8 * j + 3]);
            w.z = pg8::pk_bf16(st[b][8 * j + 4], st[b][8 * j + 5]); w.w = pg8::pk_bf16(st[b][8 * j + 6], st[b][8 * j + 7]); pf[b][j] = __builtin_bit_cast(bf16x8, w); }
    const int half = (lane >> 4) & 1, qp = (lane & 15) >> 2, p = lane & 3, c3 = 2 * half + (p >> 1);
    LAS const unsigned char* vbase0 = vb + 64 * (4 * hi + qp) + 16 * (c3 ^ hi) + 8 * (p & 1);
    LAS const unsigned char* vbase1 = vb + 64 * (4 * hi + qp) + 16 * (c3 ^ (2 + hi)) + 8 * (p & 1) + 2048;
#pragma unroll
    for (int d = 0; d < 4; ++d) {
        __builtin_amdgcn_sched_barrier(0);
#pragma unroll
        for (int b = 0; b < 2; ++b)
#pragma unroll
            for (int j = 0; j < 2; ++j) {
                const int co = 2048 * (4 * b + 2 * j) + 512 * d;
                const s16x4 lo = vtr(vbase0 + co), hh = vtr(vbase1 + co);
                const bf16x8 vf = {lo[0], lo[1], lo[2], lo[3], hh[0], hh[1], hh[2], hh[3]};
                o[d] = __builtin_amdgcn_mfma_f32_32x32x16_bf16(vf, pf[b][j], o[d], 0, 0, 0);
            }
    }
    __builtin_amdgcn_sched_barrier(0);
}

__device__ __forceinline__ void diff_unit(int b, int h, int i, const bf16_t* P, bf16_t* AO, float lam, const float* subln_g, LAS unsigned char* lds, int tid) {
    const int lane = tid & 63, wid = __builtin_amdgcn_readfirstlane(tid >> 6), w4 = wid >> 1, j = wid & 1, l32 = lane & 31, hi = lane >> 5;
    const size_t rowbase = (size_t)b * 4096; const int q0 = 128 * i + 32 * w4;
    bf16x8 qf[4];
    { const bf16_t* qp = P + (rowbase + q0 + l32) * PITCH + h * 128 + j * 64 + 8 * hi;
#pragma unroll
      for (int s = 0; s < 4; ++s) qf[s] = *(const bf16x8*)(qp + 16 * s); }
    const bf16_t* Kg = P + rowbase * PITCH + 1024 + h * 128; const bf16_t* Vg = P + rowbase * PITCH + 2048 + h * 128;
    f32x16 o[4];
#pragma unroll
    for (int d = 0; d < 4; ++d)
#pragma unroll
        for (int r = 0; r < 16; ++r) o[d][r] = 0.f;
    float m = NEG, l = 0.f;
    const int NT = 2 * (i + 1);
    TileRegs R;
    tile_load(R, Kg, Vg, tid); tile_store(R, lds + OFF_K, lds + OFF_V, tid); __syncthreads();
    for (int t = 0; t < NT; ++t) {
        const int cur = t & 1;
        if (t + 1 < NT) tile_load(R, Kg + (size_t)(t + 1) * 64 * PITCH, Vg + (size_t)(t + 1) * 64 * PITCH, tid);
        const int key0 = 64 * t;
        if (key0 <= q0 + 31) tile_compute<4>(o, m, l, qf, lds + OFF_K + cur * 16384, lds + OFF_V + cur * 16384, 8 * j, lane, key0 + 63 > q0, q0 + l32 - key0, true);
        if (t + 1 < NT) tile_store(R, lds + OFF_K + (cur ^ 1) * 16384, lds + OFF_V + (cur ^ 1) * 16384, tid);
        __syncthreads();
    }
    const float inv = 1.0f / xsum32(l);
#pragma unroll
    for (int d = 0; d < 4; ++d) o[d] = o[d] * inv;
    LAS float* xb = (LAS float*)lds + w4 * 4096;
    if (j == 1) {
#pragma unroll
        for (int d = 0; d < 4; ++d)
#pragma unroll
            for (int r = 0; r < 16; ++r) xb[(d * 16 + r) * 64 + lane] = o[d][r];
    }
    __syncthreads();
    if (j == 0) {
        float ssq = 0.f;
#pragma unroll
        for (int d = 0; d < 4; ++d)
#pragma unroll
            for (int r = 0; r < 16; ++r) { const float v = o[d][r] - lam * xb[(d * 16 + r) * 64 + lane]; o[d][r] = v; ssq += v * v; }
        ssq = xsum32(ssq);
        const float rn = rsqrtf(ssq * (1.0f / 128.0f) + 1e-5f) * 0.8f;
        bf16_t* op = AO + (rowbase + q0 + l32) * AOP + h * 128 + 4 * hi;
#pragma unroll
        for (int d = 0; d < 4; ++d)
#pragma unroll
            for (int g = 0; g < 4; ++g) { const f32x4 gg = *(const f32x4*)(subln_g + 32 * d + 8 * g + 4 * hi);
                u32x2 w; w.x = pg8::pk_bf16(o[d][4 * g] * rn * gg[0], o[d][4 * g + 1] * rn * gg[1]); w.y = pg8::pk_bf16(o[d][4 * g + 2] * rn * gg[2], o[d][4 * g + 3] * rn * gg[3]);
                *(u32x2*)(op + 32 * d + 8 * g) = w; }
    }
    __syncthreads();
}

__device__ __forceinline__ void moba_unit(int b, int h, int blk, const bf16_t* P, bf16_t* AO, const float* kpart, LAS unsigned char* lds, int tid) {
    const int lane = tid & 63, wid = __builtin_amdgcn_readfirstlane(tid >> 6), l32 = lane & 31, hi = lane >> 5;
    const size_t rowbase = (size_t)b * 4096; const int q0 = 256 * blk + 32 * wid;
    bf16x8 qf[8];
    { const bf16_t* qp = P + (rowbase + q0 + l32) * PITCH + 3072 + h * 128 + 8 * hi;
#pragma unroll
      for (int s = 0; s < 8; ++s) qf[s] = *(const bf16x8*)(qp + 16 * s); }
    const bf16_t* Kg = P + rowbase * PITCH + 4096 + h * 128; const bf16_t* Vg = P + rowbase * PITCH + 5120 + h * 128;
    LAS float* km = (LAS float*)(lds + OFF_KM);
    for (int idx = tid; idx < blk * 128; idx += 512) { const int n = idx >> 7, d = idx & 127; const float* kp = kpart + (size_t)((b * 16 + n) * 2) * 1024 + h * 128 + d; km[idx] = kp[0] + kp[1024]; }
    TileRegs R;
    tile_load(R, Kg + (size_t)(256 * blk) * PITCH, Vg + (size_t)(256 * blk) * PITCH, tid); tile_store(R, lds + OFF_K, lds + OFF_V, tid);
    __syncthreads();
    unsigned selmask = 0u;
    {
        float tv0 = -INFINITY, tv1 = -INFINITY, tv2 = -INFINITY; int ti0 = -1, ti1 = -1, ti2 = -1;
        for (int n = 0; n < blk; ++n) {
            float part = 0.f;
#pragma unroll
            for (int s = 0; s < 8; ++s) { const LAS float* kp = km + n * 128 + 16 * s + 8 * hi; const f32x4 ka = *(const LAS f32x4*)kp, kc = *(const LAS f32x4*)(kp + 4);
                part += bf2f(qf[s][0]) * ka[0] + bf2f(qf[s][1]) * ka[1] + bf2f(qf[s][2]) * ka[2] + bf2f(qf[s][3]) * ka[3] + bf2f(qf[s][4]) * kc[0] + bf2f(qf[s][5]) * kc[1] + bf2f(qf[s][6]) * kc[2] + bf2f(qf[s][7]) * kc[3]; }
            const float tot = xsum32(part);
            if (tot > tv0) { tv2 = tv1; ti2 = ti1; tv1 = tv0; ti1 = ti0; tv0 = tot; ti0 = n; }
            else if (tot > tv1) { tv2 = tv1; ti2 = ti1; tv1 = tot; ti1 = n; }
            else if (tot > tv2) { tv2 = tot; ti2 = n; }
        }
        if (ti0 >= 0) selmask |= 1u << ti0; if (ti1 >= 0) selmask |= 1u << ti1; if (ti2 >= 0) selmask |= 1u << ti2;
    }
    f32x16 o[4];
#pragma unroll
    for (int d = 0; d < 4; ++d)
#pragma unroll
        for (int r = 0; r < 16; ++r) o[d][r] = 0.f;
    float m = NEG, l = 0.f;
    const int NT = 4 + 4 * blk;
    for (int t = 0; t < NT; ++t) {
        const int cur = t & 1;
        if (t + 1 < NT) { const int t1 = t + 1; const int key0n = (t1 < 4) ? 256 * blk + 64 * t1 : 64 * (t1 - 4); tile_load(R, Kg + (size_t)key0n * PITCH, Vg + (size_t)key0n * PITCH, tid); }
        bool doit, causal, sel; int qd;
        if (t < 4) { const int kr = 64 * t, qr0 = 32 * wid; doit = kr <= qr0 + 31; causal = kr + 63 > qr0; qd = qr0 + l32 - kr; sel = true; }
        else { const int n = (t - 4) >> 2; sel = (selmask >> n) & 1u; doit = __any(sel); causal = false; qd = 0; }
        if (doit) tile_compute<8>(o, m, l, qf, lds + OFF_K + cur * 16384, lds + OFF_V + cur * 16384, 0, lane, causal, qd, sel);
        if (t + 1 < NT) tile_store(R, lds + OFF_K + (cur ^ 1) * 16384, lds + OFF_V + (cur ^ 1) * 16384, tid);
        __syncthreads();
    }
    const float inv = 1.0f / xsum32(l);
    bf16_t* op = AO + (rowbase + q0 + l32) * AOP + 1024 + h * 128 + 4 * hi;
#pragma unroll
    for (int d = 0; d < 4; ++d)
#pragma unroll
        for (int g = 0; g < 4; ++g) { u32x2 w; w.x = pg8::pk_bf16(o[d][4 * g] * inv, o[d][4 * g + 1] * inv); w.y = pg8::pk_bf16(o[d][4 * g + 2] * inv, o[d][4 * g + 3] * inv); *(u32x2*)(op + 32 * d + 8 * g) = w; }
}
}
#define LAS __attribute__((address_space(3)))
typedef unsigned short bf16;
typedef unsigned v4u __attribute__((ext_vector_type(4)));
typedef unsigned v2u __attribute__((ext_vector_type(2)));
typedef float f32x4 __attribute__((ext_vector_type(4)));
#ifndef ATT_REPS
#define ATT_REPS 1
#endif
#ifndef SKIPMASK
#define SKIPMASK 0
#endif
constexpr int NWAVES = 8;
constexpr int N_LAUNCHES = MK_N_LAUNCHES;
constexpr int NPH = 9;
constexpr int SEQ = 4096, NB = 4, M = NB * SEQ, D = 2048, NPROJ = 6144, FF = 5632, NUP = 2 * FF;
constexpr float LN_EPS = 1e-5f;
constexpr float ALPHA = 1.189207115002721f;
constexpr float LOG2E = 1.4426950408889634f;
constexpr size_t MiB = 1u << 20;
constexpr size_t WS_CTL = 0;
constexpr size_t WS_TABD = 1 * MiB, WS_TABM = WS_TABD + 4096 * 16 * 4;
constexpr size_t WS_KPART = 2 * MiB;
constexpr size_t WS_WUP = 4 * MiB, WS_WDOWN = 48 * MiB, WS_WIN = 72 * MiB, WS_WOUT = 96 * MiB;
constexpr size_t WS_XB = 104 * MiB, WS_P = 168 * MiB, WS_AO = 360 * MiB;
constexpr size_t WS_ACT = 168 * MiB;
constexpr size_t WS_HG = 424 * MiB, WS_FX = 428 * MiB;
constexpr size_t WS_H1B = 448 * MiB, WS_END = 512 * MiB;
static_assert(WS_ACT + (size_t)M * FF * 2 <= WS_AO && WS_FX + (size_t)64 * 4 * FF * 4 <= WS_H1B && WS_AO + (size_t)M * D * 2 <= WS_H1B && WS_WIN + (size_t)NPROJ * D * 2 <= WS_WOUT && WS_WDOWN + (size_t)D * FF * 2 <= WS_WIN, "ws map");
constexpr int LDS_BYTES = 147456;
constexpr int LDS_MISC = 131072;

struct Args { const float* in[16]; float* out; unsigned char* ws; float invD[8]; float invM[16]; int ph_lo, ph_hi; };

__device__ __forceinline__ float wave_sum(float v) {
#pragma unroll
    for (int o = 1; o < 64; o <<= 1) v += __shfl_xor(v, o);
    return v;
}
template <int UPMAP> __device__ __forceinline__ void p0_transpose_item(const float* W, int K, int N, bf16* WT, LAS float* scr, int item, int lane) {
    const int nblk = N / 32, kb = item / nblk, nb = item % nblk, k0 = 64 * kb, n0 = 32 * nb;
    const int r0 = UPMAP ? ((n0 < 5632) ? 256 * (n0 >> 7) + (n0 & 127) : 256 * ((n0 - 5632) >> 7) + 128 + ((n0 - 5632) & 127)) : n0;
#pragma unroll 8
    for (int i = 0; i < 32; ++i) { const int kk = 2 * i + (lane >> 5); scr[kk * 33 + (lane & 31)] = W[(size_t)(k0 + kk) * N + n0 + (lane & 31)]; }
    asm volatile("s_waitcnt lgkmcnt(0)" ::: "memory");
    const int c = lane & 7;
#pragma unroll
    for (int j = 0; j < 4; ++j) { const int n = (lane >> 3) + 8 * j; const LAS float* s = scr + (8 * c) * 33 + n;
        v4u o; o.x = pg8::pk_bf16(s[0 * 33], s[1 * 33]); o.y = pg8::pk_bf16(s[2 * 33], s[3 * 33]); o.z = pg8::pk_bf16(s[4 * 33], s[5 * 33]); o.w = pg8::pk_bf16(s[6 * 33], s[7 * 33]);
        *(v4u*)(WT + (size_t)(r0 + n) * K + k0 + 8 * c) = o; }
    asm volatile("s_waitcnt lgkmcnt(0)" ::: "memory");
}
__device__ __forceinline__ void ln_rows(float* io, bf16* ob, const float* g, const float* bta, int gw, int NGW, int lane) {
    for (int m = gw; m < M; m += NGW) {
        f32x4* xr = (f32x4*)(io + (size_t)m * D) + lane;
        f32x4 v[8]; float s = 0.f;
#pragma unroll
        for (int j = 0; j < 8; ++j) { v[j] = xr[64 * j]; s += (v[j].x + v[j].y) + (v[j].z + v[j].w); }
        const float mean = wave_sum(s) * (1.f / D); float s2 = 0.f;
#pragma unroll
        for (int j = 0; j < 8; ++j) { v[j] = v[j] - mean; s2 += (v[j].x * v[j].x + v[j].y * v[j].y) + (v[j].z * v[j].z + v[j].w * v[j].w); }
        const float rstd = rsqrtf(wave_sum(s2) * (1.f / D) + LN_EPS);
#pragma unroll
        for (int j = 0; j < 8; ++j) { const f32x4 gg = *((const f32x4*)g + lane + 64 * j), bb = *((const f32x4*)bta + lane + 64 * j);
            const f32x4 y = v[j] * rstd * gg + bb; xr[64 * j] = y;
            if (ob) { v2u w; w.x = pg8::pk_bf16(y.x, y.y); w.y = pg8::pk_bf16(y.z, y.w); *((v2u*)(ob + (size_t)m * D) + lane + 64 * j) = w; } }
    }
}

__global__ void __launch_bounds__(NWAVES * 64, 2) mega(Args args) {
    extern __shared__ __attribute__((aligned(16))) unsigned char lds_raw[];
    LAS unsigned char* lds = (LAS unsigned char*)lds_raw;
    cg::grid_group grid = cg::this_grid();
    const int G = gridDim.x, bx = blockIdx.x;
#define TIDS() int tid = threadIdx.x; asm volatile("" : "+v"(tid)); const int lane = tid & 63, wave = __builtin_amdgcn_readfirstlane(tid >> 6); const int gw = bx * NWAVES + wave, NGW = G * NWAVES; (void)lane; (void)gw; (void)NGW
    const int lo = args.ph_lo, hi = args.ph_hi;
#define IN(k) (lo <= (k) && (k) < hi)
#define SEAM(k) do { if (IN(k) && IN((k) + 1)) grid.sync(); } while (0)

    if (IN(0) && !(SKIPMASK & (1 << 0))) { TIDS();
        const float* x = args.in[0]; const float* w_in = args.in[1]; const float* w_out = args.in[7]; const float* w_up = args.in[10]; const float* w_down = args.in[13]; unsigned char* ws = args.ws; unsigned* ctl = (unsigned*)(ws + WS_CTL); float* tabD = (float*)(ws + WS_TABD); float* tabM = (float*)(ws + WS_TABM); bf16* Wt_in = (bf16*)(ws + WS_WIN); bf16* Wt_out = (bf16*)(ws + WS_WOUT); bf16* Wt_up = (bf16*)(ws + WS_WUP); bf16* Wt_down = (bf16*)(ws + WS_WDOWN); bf16* XB = (bf16*)(ws + WS_XB);

        if (bx == 0 && tid == 0) { ctl[0] = 0u; ctl[64] = 0u; }
        LAS float* scr = (LAS float*)(lds + wave * 16384);
        constexpr int I_IN = (D / 64) * (NPROJ / 32), I_OUT = (D / 64) * (D / 32), I_UP = (D / 64) * (NUP / 32), I_DN = (FF / 64) * (D / 32);
        constexpr int NITEMS = I_IN + I_OUT + I_UP + I_DN;
        for (int it = gw; it < NITEMS; it += NGW) {
            int r = it;
            if (r < I_IN) { p0_transpose_item<0>(w_in, D, NPROJ, Wt_in, scr, r, lane); continue; } r -= I_IN;
            if (r < I_OUT) { p0_transpose_item<0>(w_out, D, D, Wt_out, scr, r, lane); continue; } r -= I_OUT;
            if (r < I_UP) { p0_transpose_item<1>(w_up, D, NUP, Wt_up, scr, r, lane); continue; } r -= I_UP;
            p0_transpose_item<0>(w_down, FF, D, Wt_down, scr, r, lane);
        }
        const int gt = bx * (NWAVES * 64) + tid, NGT = G * NWAVES * 64;
        for (size_t i = gt; i < (size_t)M * D / 8; i += NGT) { const f32x4 a = ((const f32x4*)x)[2 * i], b = ((const f32x4*)x)[2 * i + 1];
            v4u o; o.x = pg8::pk_bf16(a.x, a.y); o.y = pg8::pk_bf16(a.z, a.w); o.z = pg8::pk_bf16(b.x, b.y); o.w = pg8::pk_bf16(b.z, b.w); ((v4u*)XB)[i] = o; }
        for (int i = gt; i < SEQ * 24; i += NGT) { const int pos = i / 24, k = i % 24;
            if (k < 8) { const float ang = (float)pos * args.invD[k]; tabD[pos * 16 + k] = cosf(ang); tabD[pos * 16 + 8 + k] = sinf(ang); }
            else { const int kk = k - 8; const float ang = (float)pos * args.invM[kk]; tabM[pos * 32 + kk] = cosf(ang); tabM[pos * 32 + 16 + kk] = sinf(ang); } }
    }
    SEAM(0);
    if (IN(1) && !(SKIPMASK & (1 << 1))) { TIDS();
        unsigned char* ws = args.ws; float* tabD = (float*)(ws + WS_TABD); float* tabM = (float*)(ws + WS_TABM); float* kpart = (float*)(ws + WS_KPART); bf16* Wt_in = (bf16*)(ws + WS_WIN); bf16* XB = (bf16*)(ws + WS_XB); bf16* P = (bf16*)(ws + WS_P);

        pg8::Gemm g{XB, Wt_in, M, NPROJ, D, D}; pg8::StaticOrder S; S.init(M, NPROJ, G, bx);
        pg8::EpiProj E{P, tabD, tabM, kpart, 0.125f * LOG2E, 0.08838834764831845f * LOG2E};
        pg8::gemm_phase<pg8::EpiProj, pg8::StaticOrder, true, true>(lds, g, S, E);
    }
    SEAM(1);
    if (IN(2) && !(SKIPMASK & (1 << 2))) { TIDS();
        const float* lq1 = args.in[2]; const float* lk1 = args.in[3]; const float* lq2 = args.in[4]; const float* lk2 = args.in[5]; const float* subln_g = args.in[6]; unsigned char* ws = args.ws; unsigned* ctl = (unsigned*)(ws + WS_CTL); float* kpart = (float*)(ws + WS_KPART); bf16* P = (bf16*)(ws + WS_P); bf16* AO = (bf16*)(ws + WS_AO);

        float lam;
        { const float a = wave_sum(lq1[lane] * lk1[lane]), b = wave_sum(lq2[lane] * lk2[lane]); lam = expf(a) - expf(b) + 0.2f; }
        volatile LAS int* slot = (volatile LAS int*)(lds + att::OFF_SLOT);
        for (int rep = 0; rep < ATT_REPS; ++rep)
        for (;;) {
            __syncthreads();
            if (tid == 0) *slot = (int)atomicAdd(ctl + 64 * rep, 1u);
            __syncthreads();
            const int idx = *slot;
            if (idx >= 1536) break;
            const int gq = 15 - idx / 96, rem = idx % 96, type = rem >> 5, bh = rem & 31, b = bh >> 3, h = bh & 7;
            if (type == 0) {
#ifndef NO_MOBA
 att::moba_unit(b, h, gq, P, AO, kpart, lds, tid);
#endif
 }
            else
#ifndef NO_DIFF
 att::diff_unit(b, h, type == 1 ? 2 * gq + 1 : 2 * gq, P, AO, lam, subln_g, lds, tid);
#else
 ;
#endif
        }
    }
    SEAM(2);
    if (IN(3) && !(SKIPMASK & (1 << 3))) { TIDS();
        const float* x = args.in[0]; float* out = args.out; unsigned char* ws = args.ws; bf16* AO = (bf16*)(ws + WS_AO); bf16* Wt_out = (bf16*)(ws + WS_WOUT);

        pg8::Gemm g{AO, Wt_out, M, D, D, D}; pg8::StaticOrder S; S.init(M, D, G, bx);
        pg8::EpiResid E{x, out, D, ALPHA};
        pg8::gemm_phase<pg8::EpiResid, pg8::StaticOrder, true, true>(lds, g, S, E);
    }
    SEAM(3);
    if (IN(4) && !(SKIPMASK & (1 << 4))) { TIDS(); const float* ln1_g = args.in[8]; const float* ln1_b = args.in[9]; float* out = args.out; unsigned char* ws = args.ws; bf16* H1B = (bf16*)(ws + WS_H1B); ln_rows(out, H1B, ln1_g, ln1_b, gw, NGW, lane); }
    SEAM(4);
    if (IN(5) && !(SKIPMASK & (1 << 5))) { TIDS();
        const float* conv_w = args.in[11]; const float* conv_b = args.in[12]; unsigned char* ws = args.ws;
        pg8::Gemm g{(bf16*)(ws + WS_H1B), (bf16*)(ws + WS_WUP), M, NUP, D, D}; pg8::StaticOrder S; S.init(M, NUP, G, bx);
        pg8::EpiConvGate E{(bf16*)(ws + WS_ACT), conv_w, conv_b, (float*)(ws + WS_HG), (float*)(ws + WS_FX), (LAS float*)(lds + LDS_MISC)};
        pg8::gemm_phase<pg8::EpiConvGate, pg8::StaticOrder, true, true>(lds, g, S, E);
    }
    SEAM(5);
    if (IN(7) && !(SKIPMASK & (1 << 7))) { TIDS();
        const float* conv_w = args.in[11]; float* out = args.out; unsigned char* ws = args.ws;
        bf16* ACT = (bf16*)(ws + WS_ACT); const float* HG = (const float*)(ws + WS_HG); const float* FX = (const float*)(ws + WS_FX);
        pg8::StaticOrder S; S.init(M, D, G, bx);
        { pg8::Unit u; int last = -1;
          for (int i = 0; S.next(i, u); ++i) { const int pm = u.pm; if ((pm & 15) == 0 || pm == last) continue; last = pm;
            for (int idx = tid; idx < 2 * (FF / 4); idx += NWAVES * 64) { const int r = idx / (FF / 4), f = 4 * (idx % (FF / 4));
                const f32x4 gp = *(const f32x4*)(FX + (((size_t)pm * 2 + r) * 2) * FF + f), vv = *(const f32x4*)(FX + (((size_t)pm * 2 + r) * 2 + 1) * FF + f);
                const f32x4 h1 = *(const f32x4*)(HG + ((size_t)(pm - 1) * 2 + 1) * FF + f), h2 = *(const f32x4*)(HG + ((size_t)(pm - 1) * 2) * FF + f);
                const f32x4 w0 = *(const f32x4*)(conv_w + f), w1 = *(const f32x4*)(conv_w + FF + f);
                const f32x4 gc = (r == 0) ? gp + w1 * h1 + w0 * h2 : gp + w0 * h1;
                f32x4 a;
#pragma unroll
                for (int e = 0; e < 4; ++e) a[e] = vv[e] * gc[e] * __builtin_amdgcn_rcpf(1.f + __builtin_amdgcn_exp2f(-1.4426950408889634f * gc[e]));
                v2u w; w.x = pg8::pk_bf16(a[0], a[1]); w.y = pg8::pk_bf16(a[2], a[3]);
                *(v2u*)(ACT + (size_t)(pm * 256 + r) * FF + f) = w; } }
          __threadfence(); __syncthreads(); }
        pg8::Gemm g{ACT, (bf16*)(ws + WS_WDOWN), M, D, FF, FF};
        pg8::EpiResid E{out, out, D, ALPHA};
        pg8::gemm_phase<pg8::EpiResid, pg8::StaticOrder, true, true>(lds, g, S, E);
    }
    SEAM(7);
    if (IN(8) && !(SKIPMASK & (1 << 8))) { TIDS(); const float* ln2_g = args.in[14]; const float* ln2_b = args.in[15]; float* out = args.out; ln_rows(out, nullptr, ln2_g, ln2_b, gw, NGW, lane); }
#undef IN
#undef SEAM
}

extern "C" void kernel_launch(void* const* d_in, const int* in_sizes, int n_in, void* d_out, int out_size, void* d_ws, size_t ws_size, hipStream_t stream) {
    static int grid = 0;
    if (grid == 0) {
        if (n_in != 16 || in_sizes[0] != M * D || out_size != M * D || ws_size < WS_END) { fprintf(stderr, "kernel_launch: unexpected shapes (n_in %d, in0 %d, out %d, ws %zu); nothing launched\n", n_in, n_in > 0 ? in_sizes[0] : -1, out_size, ws_size); grid = -1; return; }
        int dev = 0, cus = 0, per_cu = 0;
        if (hipGetDevice(&dev) != hipSuccess || hipDeviceGetAttribute(&cus, hipDeviceAttributeMultiprocessorCount, dev) != hipSuccess) { grid = -1; return; }
        if (hipFuncSetAttribute((const void*)mega, hipFuncAttributeMaxDynamicSharedMemorySize, LDS_BYTES) != hipSuccess) { fprintf(stderr, "kernel_launch: hipFuncSetAttribute failed\n"); grid = -1; return; }
        if (hipOccupancyMaxActiveBlocksPerMultiprocessor(&per_cu, (const void*)mega, NWAVES * 64, LDS_BYTES) != hipSuccess || per_cu < 1) { fprintf(stderr, "kernel_launch: occupancy query failed (%d)\n", per_cu); (void)hipGetLastError(); per_cu = 1; }
        grid = cus * per_cu;
    }
    if (grid < 0) return;
    Args a{};
    for (int i = 0; i < 16; ++i) a.in[i] = (const float*)d_in[i];
    a.out = (float*)d_out; a.ws = (unsigned char*)d_ws;
    for (int i = 0; i < 8; ++i) a.invD[i] = (float)(1.0 / pow(500000.0, (double)(2 * i) / 16.0));
    for (int i = 0; i < 16; ++i) a.invM[i] = (float)(1.0 / pow(500000.0, (double)(2 * i) / 32.0));
    if (N_LAUNCHES == 1) {
        a.ph_lo = 0; a.ph_hi = NPH;
        void* kargs[] = {&a};
        hipError_t e = hipLaunchCooperativeKernel((const void*)mega, dim3(grid), dim3(NWAVES * 64), kargs, LDS_BYTES, stream);
        if (e != hipSuccess) fprintf(stderr, "cooperative launch failed: %s (grid %d)\n", hipGetErrorString(e), grid);
    } else {
        for (int ph = 0; ph < NPH; ++ph) { a.ph_lo = ph; a.ph_hi = ph + 1; hipLaunchKernelGGL(mega, dim3(grid), dim3(NWAVES * 64), LDS_BYTES, stream, a); }
    }
}
```

```cpp
#include <hip/hip_runtime.h>
#include <hip/hip_cooperative_groups.h>
#include <cstdio>
#include <cstdint>
#include <cmath>
namespace cg = cooperative_groups;
#ifndef MK_N_LAUNCHES
#define MK_N_LAUNCHES 1
#endif
namespace pg8 {
#define PG8_LAS __attribute__((address_space(3)))
typedef unsigned short bf16_t;
typedef short bf16x8 __attribute__((ext_vector_type(8)));
typedef float f32x4 __attribute__((ext_vector_type(4)));
typedef unsigned u32x4 __attribute__((ext_vector_type(4)));
constexpr int BM = 256, BK = 64, HALF = 128, HTB = HALF * BK * 2  , STAGE_BYTES = 8 * HTB, NXCD = 8, WGM = 8;

__host__ __device__ __forceinline__ int lds_byte(int r, int c) { const int st = (r >> 4) * 2 + (c >> 5), rr = r & 15, cc = c & 31, ob = rr * 64 + cc * 2; return st * 1024 + (ob ^ (((ob >> 9) & 1) << 5)); }
__host__ __device__ __forceinline__ void stage_rc(int b, int& R, int& C) { const int st = b / 1024, sb = b % 1024, swz = sb ^ (((sb >> 9) & 1) << 5); R = (st >> 1) * 16 + swz / 64; C = (st & 1) * 32 + (swz % 64) / 2; }
__host__ __device__ __forceinline__ int perm32(int rho) { const int n = rho >> 4, i = rho & 15; return 8 * (i >> 2) + 4 * n + (i & 3); }

struct Unit { int pm, pn; };
struct Gemm { const bf16_t* A; const bf16_t* Bt; int M, N, K, lda; };

struct StaticOrder {
    int nM, nN, nwg, G, c;
    __host__ __device__ void init(int M, int N, int G_, int c_) { nM = M / BM; nN = N / BM; nwg = nM * nN; G = G_; c = c_; }
    __host__ __device__ bool next(int i, Unit& u) const {
        const long L = (long)i * G + c; if (L >= nwg) return false;
        int wgid = (int)L; { const int q = nwg / NXCD, r = nwg % NXCD, xcd = wgid % NXCD, off = wgid / NXCD; wgid = (xcd < r ? xcd * (q + 1) : r * (q + 1) + (xcd - r) * q) + off; }
        const int nig = WGM * nN, gid = wgid / nig, fm = gid * WGM, gsz = (nM - fm) < WGM ? (nM - fm) : WGM;
        u.pm = fm + ((wgid % nig) % gsz); u.pn = (wgid % nig) / gsz; return true;
    }
    __device__ __forceinline__ void a_ready(const Unit&) const {}
    __device__ __forceinline__ void done(const Unit&) const {}
};

__device__ __forceinline__ unsigned cvt_pk_bf16(float lo, float hi) { unsigned r; asm volatile("v_cvt_pk_bf16_f32 %0, %1, %2" : "=v"(r) : "v"(lo), "v"(hi)); return r; }
typedef float f32x2 __attribute__((ext_vector_type(2)));
typedef float f32x2 __attribute__((ext_vector_type(2)));
typedef __bf16 bf16x2_t __attribute__((ext_vector_type(2)));
__device__ __forceinline__ unsigned pk_bf16(float lo, float hi) { f32x2 v = {lo, hi}; bf16x2_t b = __builtin_convertvector(v, bf16x2_t); return __builtin_bit_cast(unsigned, b); }

struct EpiPlainBf16 {
    static constexpr bool PERM = true, AFTER_DRAIN = false;
    bf16_t* O; int ldc;
    __device__ __forceinline__ void operator()(const f32x4 (&acc)[2][2][4][2], const Unit& u, int wr, int wc, int fr, int fq) const {
        const int row0 = u.pm * BM + wr * 64 + fr, col0 = u.pn * BM + wc * 32 + 8 * fq;
#pragma unroll
        for (int ai = 0; ai < 2; ++ai)
#pragma unroll
            for (int m = 0; m < 4; ++m) { bf16_t* rowp = O + (size_t)(row0 + ai * HALF + m * 16) * ldc + col0;
#pragma unroll
                for (int bj = 0; bj < 2; ++bj) { const f32x4 v0 = acc[ai][bj][m][0], v1 = acc[ai][bj][m][1];
                    u32x4 w; w.x = pk_bf16(v0[0], v0[1]); w.y = pk_bf16(v0[2], v0[3]); w.z = pk_bf16(v1[0], v1[1]); w.w = pk_bf16(v1[2], v1[3]);
                    *(u32x4*)(rowp + bj * HALF) = w; } }
    }
};

struct EpiProj {
    static constexpr bool PERM = true, AFTER_DRAIN = false;
    bf16_t* O; const float* tabD; const float* tabM; float* kpart; float qscale_d, qscale_m;
    __device__ __forceinline__ void operator()(const f32x4 (&acc)[2][2][4][2], const Unit& u, int wr, int wc, int fr, int fq) const {
        const int region = u.pn >> 2;
        const int row0 = u.pm * BM + wr * 64 + fr, col0 = u.pn * BM + wc * 32 + 8 * fq;
        const bool ropeD = (region <= 1) && ((wc & 1) == 0);
        const bool ropeM = (region == 3 || region == 4) && (wc == 0);
        const float sc = region == 0 ? qscale_d : (region == 3 ? qscale_m : 1.f);
        f32x4 ks[2][2];
#pragma unroll
        for (int bj = 0; bj < 2; ++bj) { ks[bj][0] = (f32x4){0.f, 0.f, 0.f, 0.f}; ks[bj][1] = (f32x4){0.f, 0.f, 0.f, 0.f}; }
#pragma unroll
        for (int ai = 0; ai < 2; ++ai)
#pragma unroll
            for (int m = 0; m < 4; ++m) {
                const int r = row0 + ai * HALF + m * 16, pos = r & 4095;
                f32x4 c0 = {1.f, 1.f, 1.f, 1.f}, c1 = c0, s0 = {0.f, 0.f, 0.f, 0.f}, s1 = s0;
                if (ropeD) { const float* t = tabD + pos * 16; c0 = *(const f32x4*)t; c1 = *(const f32x4*)(t + 4); s0 = *(const f32x4*)(t + 8); s1 = *(const f32x4*)(t + 12); }
                else if (ropeM) { const float* t = tabM + pos * 32 + 8 * (fq & 1); c0 = *(const f32x4*)t; c1 = *(const f32x4*)(t + 4); s0 = *(const f32x4*)(t + 16); s1 = *(const f32x4*)(t + 20); }
                bf16_t* rowp = O + (size_t)r * 6144 + col0;
#pragma unroll
                for (int bj = 0; bj < 2; ++bj) {
                    f32x4 v0 = acc[ai][bj][m][0], v1 = acc[ai][bj][m][1];
                    if (ropeD) {
                        f32x4 p0, p1;
#pragma unroll
                        for (int e = 0; e < 4; ++e) { p0[e] = __shfl_xor(v0[e], 16); p1[e] = __shfl_xor(v1[e], 16); }
                        const f32x4 sg0 = (fq == 0) ? -s0 : s0, sg1 = (fq == 0) ? -s1 : s1;
                        const f32x4 n0 = v0 * c0 + p0 * sg0, n1 = v1 * c1 + p1 * sg1;
                        if (fq < 2) { v0 = n0; v1 = n1; }
                    } else if (ropeM) {
                        f32x4 p0, p1;
#pragma unroll
                        for (int e = 0; e < 4; ++e) { p0[e] = __shfl_xor(v0[e], 32); p1[e] = __shfl_xor(v1[e], 32); }
                        const f32x4 sg0 = (fq < 2) ? -s0 : s0, sg1 = (fq < 2) ? -s1 : s1;
                        v0 = v0 * c0 + p0 * sg0; v1 = v1 * c1 + p1 * sg1;
                    }
                    v0 = v0 * sc; v1 = v1 * sc;
                    ks[bj][0] += v0; ks[bj][1] += v1;
                    u32x4 w; w.x = pk_bf16(v0[0], v0[1]); w.y = pk_bf16(v0[2], v0[3]); w.z = pk_bf16(v1[0], v1[1]); w.w = pk_bf16(v1[2], v1[3]);
                    *(u32x4*)(rowp + bj * HALF) = w;
                }
            }
        if (region == 4) {
#pragma unroll
            for (int bj = 0; bj < 2; ++bj)
#pragma unroll
                for (int n = 0; n < 2; ++n)
#pragma unroll
                    for (int e = 0; e < 4; ++e) { float v = ks[bj][n][e]; v += __shfl_xor(v, 1); v += __shfl_xor(v, 2); v += __shfl_xor(v, 4); v += __shfl_xor(v, 8); ks[bj][n][e] = v; }
            if (fr == 0) {
                float* kp = kpart + (size_t)(u.pm * 2 + wr) * 1024 + (col0 - 4096);
#pragma unroll
                for (int bj = 0; bj < 2; ++bj) { *(f32x4*)(kp + bj * HALF) = ks[bj][0]; *(f32x4*)(kp + bj * HALF + 4) = ks[bj][1]; }
            }
        }
    }
};

struct EpiResid {
    static constexpr bool PERM = false, AFTER_DRAIN = false;
    const float* base; float* out; int ldc; float alpha;
    __device__ __forceinline__ void operator()(const f32x4 (&acc)[2][2][4][2], const Unit& u, int wr, int wc, int fr, int fq) const {
        const int col0 = u.pn * BM + wc * 32 + 4 * fq;
#pragma unroll
        for (int ai = 0; ai < 2; ++ai)
#pragma unroll
            for (int m = 0; m < 4; ++m) { const size_t off = (size_t)(u.pm * BM + ai * HALF + wr * 64 + m * 16 + fr) * ldc + col0;
#pragma unroll
                for (int bj = 0; bj < 2; ++bj)
#pragma unroll
                    for (int n = 0; n < 2; ++n) { const f32x4 bs = *(const f32x4*)(base + off + bj * HALF + n * 16); *(f32x4*)(out + off + bj * HALF + n * 16) = bs * alpha + acc[ai][bj][m][n]; } }
    }
};

typedef unsigned u32x2 __attribute__((ext_vector_type(2)));
struct EpiConvGate {
    static constexpr bool PERM = true, AFTER_DRAIN = false;
    bf16_t* ACT; const float* conv_w; const float* conv_b; float* HG; float* FX; PG8_LAS float* bnd;
    __device__ __forceinline__ void operator()(const f32x4 (&acc)[2][2][4][2], const Unit& u, int wr, int wc, int fr, int fq) const {
        constexpr int F = 5632;
        const int lane = fr + 16 * fq;
        const int cl = wc * 32 + 8 * fq;
        const int f0 = u.pn * 128 + cl;
        if (fr >= 14) {
#pragma unroll
            for (int ai = 0; ai < 2; ++ai) { PG8_LAS float* bp = bnd + ((2 * ai + wr) * 2 + (fr - 14)) * 128 + cl;
                *(PG8_LAS f32x4*)bp = acc[ai][0][3][0]; *(PG8_LAS f32x4*)(bp + 4) = acc[ai][0][3][1]; }
            if (wr == 1) { float* hp = HG + ((size_t)u.pm * 2 + (fr - 14)) * F + f0; *(f32x4*)hp = acc[1][0][3][0]; *(f32x4*)(hp + 4) = acc[1][0][3][1]; }
        }
        asm volatile("s_waitcnt lgkmcnt(0)\n\ts_barrier" ::: "memory");
        const int s1 = (lane & 48) | ((fr - 1) & 15), s2 = (lane & 48) | ((fr - 2) & 15);
        const bool seq_start = (u.pm & 15) == 0;
#pragma unroll
        for (int n = 0; n < 2; ++n) {
            const f32x4 w0 = *(const f32x4*)(conv_w + f0 + 4 * n), w1 = *(const f32x4*)(conv_w + F + f0 + 4 * n), w2 = *(const f32x4*)(conv_w + 2 * F + f0 + 4 * n), cb = *(const f32x4*)(conv_b + f0 + 4 * n);
#pragma unroll
            for (int ai = 0; ai < 2; ++ai) {
                __builtin_amdgcn_sched_barrier(0);
                const int ci = 2 * ai + wr;
                f32x4 bm1 = {0.f, 0.f, 0.f, 0.f}, bm2 = bm1;
                if (ci > 0) { const PG8_LAS float* bp = bnd + ((ci - 1) * 2) * 128 + cl + 4 * n; bm2 = *(const PG8_LAS f32x4*)bp; bm1 = *(const PG8_LAS f32x4*)(bp + 128); }
                f32x4 pa = bm1, pb = (fr == 0) ? bm2 : bm1;
#pragma unroll
                for (int m = 0; m < 4; ++m) {
                    const f32x4 g = acc[ai][0][m][n], vv = acc[ai][1][m][n];
                    f32x4 A, B;
#pragma unroll
                    for (int e = 0; e < 4; ++e) { A[e] = __shfl(g[e], s1); B[e] = __shfl(g[e], s2); }
                    const f32x4 p1 = (fr == 0) ? pa : A, p2 = (fr < 2) ? pb : B;
                    pa = A; pb = B;
                    const f32x4 gc = cb + w0 * p2 + w1 * p1 + w2 * g;
                    if (ai == 0 && m == 0 && wr == 0 && fr < 2 && !seq_start) { float* fp = FX + (((size_t)u.pm * 2 + fr) * 2) * F + f0 + 4 * n; *(f32x4*)fp = gc; *(f32x4*)(fp + F) = vv; }
                    f32x4 a;
#pragma unroll
                    for (int e = 0; e < 4; ++e) a[e] = vv[e] * gc[e] * __builtin_amdgcn_rcpf(1.f + __builtin_amdgcn_exp2f(-1.4426950408889634f * gc[e]));
                    u32x2 w; w.x = pk_bf16(a[0], a[1]); w.y = pk_bf16(a[2], a[3]);
                    *(u32x2*)(ACT + (size_t)(u.pm * BM + ai * HALF + wr * 64 + m * 16 + fr) * F + f0 + 4 * n) = w;
                }
            }
        }
    }
};

template <class Epi, class Sched, bool ALIGN_EPI = false, bool SP2 = false>
__device__ __forceinline__ void gemm_phase(PG8_LAS unsigned char* lds, const Gemm g, const Sched& S, const Epi& E) {
    const int tid = threadIdx.x, wid = __builtin_amdgcn_readfirstlane(tid >> 6), lane = tid & 63, wr = wid >> 2, wc = wid & 3, fr = lane & 15, fq = lane >> 4;
    const int K = g.K, nt = K / BK;
    unsigned voffA[2], voffB[2];
#pragma unroll
    for (int i = 0; i < 2; ++i) { int R, C; stage_rc(tid * 16 + i * 8192, R, C); const int Rb = Epi::PERM ? ((R & ~31) + perm32(R & 31)) : R;
        voffA[i] = (unsigned)(R * g.lda + C) * 2u; voffB[i] = (unsigned)(Rb * K + C) * 2u; }
    const size_t kstep = (size_t)(BK * 2);
    const size_t hstepB = (size_t)HALF * K * 2, hstepA = (size_t)HALF * g.lda * 2;
    const size_t tstepB = 2 * hstepB, tstepA = 2 * hstepA;
    const unsigned ldsw = (unsigned)wid * 1024u;
    const int aoff = lds_byte(wr * 64 + fr, fq * 8), boff = lds_byte(wc * 32 + fr, fq * 8);
#define PG8_SA(b, h) (((b) * 2 + (h)) * HTB)
#define PG8_SB(b, h) ((4 + (b) * 2 + (h)) * HTB)
#define PG8_STAGE(bufoff, gbase, voff) do { _Pragma("unroll") for (int _i = 0; _i < 2; ++_i) \
        __builtin_amdgcn_global_load_lds((const unsigned*)((const char*)(gbase) + (voff)[_i]), (PG8_LAS unsigned*)(lds + (bufoff) + ldsw + _i * 8192), 16, 0, 0); } while (0)
#define PG8_LDA(dst, b, h) do { _Pragma("unroll") for (int m = 0; m < 4; ++m) _Pragma("unroll") for (int k = 0; k < 2; ++k) dst[m][k] = *(const PG8_LAS bf16x8*)(lds + PG8_SA(b, h) + aoff + m * 2048 + k * 1024); } while (0)
#define PG8_LDB(dst, b, h) do { _Pragma("unroll") for (int n = 0; n < 2; ++n) _Pragma("unroll") for (int k = 0; k < 2; ++k) dst[n][k] = *(const PG8_LAS bf16x8*)(lds + PG8_SB(b, h) + boff + n * 2048 + k * 1024); } while (0)
#define PG8_MMA(ai, bj, At, Bt) do { __builtin_amdgcn_s_setprio(1); _Pragma("unroll") for (int m = 0; m < 4; ++m) _Pragma("unroll") for (int n = 0; n < 2; ++n) _Pragma("unroll") for (int k = 0; k < 2; ++k) \
        acc[ai][bj][m][n] = __builtin_amdgcn_mfma_f32_16x16x32_bf16(Bt[n][k], At[m][k], acc[ai][bj][m][n], 0, 0, 0); __builtin_amdgcn_s_setprio(0); } while (0)
#define PG8_WAIT_V(n) asm volatile("s_waitcnt vmcnt(" #n ")" ::: "memory")
#define PG8_WAIT_L(n) asm volatile("s_waitcnt lgkmcnt(" #n ")" ::: "memory")
#define PG8_BAR __builtin_amdgcn_s_barrier()
#define PG8_SCHED __builtin_amdgcn_sched_barrier(0)
    Unit cur, nxt; int ui = 0;
    if (!S.next(0, cur)) return;
    f32x4 acc[2][2][4][2];
#pragma unroll
    for (int a = 0; a < 2; ++a)
#pragma unroll
        for (int b = 0; b < 2; ++b)
#pragma unroll
            for (int m = 0; m < 4; ++m)
#pragma unroll
                for (int n = 0; n < 2; ++n) acc[a][b][m][n] = (f32x4){0.f, 0.f, 0.f, 0.f};
    bf16x8 At[4][2], B0[2][2], B1[2][2];
    const char* cA = (const char*)g.A + (size_t)cur.pm * tstepA; const char* cB = (const char*)g.Bt + (size_t)cur.pn * tstepB;
    S.a_ready(cur);
    if constexpr (SP2) {
        PG8_STAGE(PG8_SB(0, 0), cB, voffB); PG8_STAGE(PG8_SB(0, 1), cB + hstepB, voffB); PG8_STAGE(PG8_SA(0, 0), cA, voffA); PG8_STAGE(PG8_SA(0, 1), cA + hstepA, voffA);
        if (wr == 1) PG8_BAR;
        PG8_WAIT_V(2); PG8_BAR;
        PG8_STAGE(PG8_SB(1, 0), cB + kstep, voffB); PG8_STAGE(PG8_SA(1, 0), cA + kstep, voffA); PG8_STAGE(PG8_SB(1, 1), cB + hstepB + kstep, voffB);
        PG8_WAIT_V(6); PG8_BAR;
    } else {
        PG8_STAGE(PG8_SB(0, 0), cB, voffB); PG8_STAGE(PG8_SA(0, 0), cA, voffA); PG8_STAGE(PG8_SB(0, 1), cB + hstepB, voffB); PG8_STAGE(PG8_SA(0, 1), cA + hstepA, voffA);
        if (wr == 1) PG8_BAR;
        PG8_WAIT_V(4); PG8_BAR;
        PG8_STAGE(PG8_SB(1, 0), cB + kstep, voffB); PG8_STAGE(PG8_SA(1, 0), cA + kstep, voffA); PG8_STAGE(PG8_SB(1, 1), cB + hstepB + kstep, voffB);
        PG8_WAIT_V(6); PG8_BAR;
    }
    for (;;) {
        const bool has_next = S.next(ui + 1, nxt);
        const char* nA = has_next ? (const char*)g.A + (size_t)nxt.pm * tstepA : cA; const char* nB = has_next ? (const char*)g.Bt + (size_t)nxt.pn * tstepB : cB;
        for (int t = 0; t < nt; t += 2) {
            const bool last = (t == nt - 2);
            const char* a1 = cA + (size_t)(t + 1) * kstep;
            const char* a2 = last ? nA : cA + (size_t)(t + 2) * kstep; const char* b2 = last ? nB : cB + (size_t)(t + 2) * kstep;
            const char* a3 = a2 + kstep; const char* b3 = b2 + kstep;
            if (last && has_next) S.a_ready(nxt);
            if constexpr (SP2) {
            PG8_LDB(B0, 0, 0); PG8_LDB(B1, 0, 1); PG8_SCHED; PG8_LDA(At, 0, 0); PG8_STAGE(PG8_SA(1, 1), a1 + hstepA, voffA);
            PG8_WAIT_V(8); PG8_WAIT_L(0); PG8_BAR; PG8_MMA(0, 0, At, B0); PG8_MMA(0, 1, At, B1); PG8_BAR; PG8_SCHED;
            PG8_LDA(At, 0, 1); PG8_STAGE(PG8_SB(0, 0), b2, voffB); PG8_STAGE(PG8_SB(0, 1), b2 + hstepB, voffB); PG8_STAGE(PG8_SA(0, 0), a2, voffA);
            PG8_WAIT_V(8); PG8_WAIT_L(0); PG8_BAR; PG8_MMA(1, 0, At, B0); PG8_MMA(1, 1, At, B1); PG8_BAR; PG8_SCHED;
            PG8_LDB(B0, 1, 0); PG8_LDB(B1, 1, 1); PG8_SCHED; PG8_LDA(At, 1, 0); PG8_STAGE(PG8_SA(0, 1), a2 + hstepA, voffA);
            PG8_WAIT_V(8); PG8_WAIT_L(0); PG8_BAR; PG8_MMA(0, 0, At, B0); PG8_MMA(0, 1, At, B1); PG8_BAR; PG8_SCHED;
            PG8_LDA(At, 1, 1); PG8_STAGE(PG8_SB(1, 0), b3, voffB); PG8_STAGE(PG8_SB(1, 1), b3 + hstepB, voffB); PG8_STAGE(PG8_SA(1, 0), a3, voffA);
            PG8_WAIT_V(8); PG8_WAIT_L(0); PG8_BAR; PG8_MMA(1, 0, At, B0); PG8_MMA(1, 1, At, B1); PG8_BAR; PG8_SCHED;
            } else {
            PG8_LDB(B0, 0, 0); PG8_SCHED; PG8_LDA(At, 0, 0); PG8_STAGE(PG8_SA(1, 1), a1 + hstepA, voffA);
            PG8_WAIT_L(8); PG8_BAR; PG8_WAIT_L(0); PG8_MMA(0, 0, At, B0); PG8_BAR; PG8_SCHED;
            PG8_LDB(B1, 0, 1); PG8_STAGE(PG8_SB(0, 0), b2, voffB);
            PG8_BAR; PG8_WAIT_L(0); PG8_MMA(0, 1, At, B1); PG8_BAR;
            PG8_LDA(At, 0, 1); PG8_STAGE(PG8_SA(0, 0), a2, voffA);
            PG8_BAR; PG8_WAIT_L(0); PG8_MMA(1, 0, At, B0); PG8_BAR; PG8_SCHED;
            PG8_STAGE(PG8_SB(0, 1), b2 + hstepB, voffB);
            PG8_WAIT_V(6); PG8_BAR; PG8_MMA(1, 1, At, B1); PG8_BAR;
            PG8_LDB(B0, 1, 0); PG8_SCHED; PG8_LDA(At, 1, 0); PG8_STAGE(PG8_SA(0, 1), a2 + hstepA, voffA);
            PG8_WAIT_L(8); PG8_BAR; PG8_WAIT_L(0); PG8_MMA(0, 0, At, B0); PG8_BAR; PG8_SCHED;
            PG8_LDB(B1, 1, 1); PG8_STAGE(PG8_SB(1, 0), b3, voffB);
            PG8_BAR; PG8_WAIT_L(0); PG8_MMA(0, 1, At, B1); PG8_BAR;
            PG8_LDA(At, 1, 1); PG8_STAGE(PG8_SA(1, 0), a3, voffA);
            PG8_BAR; PG8_WAIT_L(0); PG8_MMA(1, 0, At, B0); PG8_BAR; PG8_SCHED;
            PG8_STAGE(PG8_SB(1, 1), b3 + hstepB, voffB);
            PG8_WAIT_V(6); PG8_BAR; PG8_MMA(1, 1, At, B1); PG8_BAR;
            }
        }
        if constexpr (ALIGN_EPI) { if (wr == 0) PG8_BAR; }
        if constexpr (!Epi::AFTER_DRAIN) { E(acc, cur, wr, wc, fr, fq); S.done(cur); }
        if (!has_next) break;
#pragma unroll
        for (int a = 0; a < 2; ++a)
#pragma unroll
            for (int b = 0; b < 2; ++b)
#pragma unroll
                for (int m = 0; m < 4; ++m)
#pragma unroll
                    for (int n = 0; n < 2; ++n) acc[a][b][m][n] = (f32x4){0.f, 0.f, 0.f, 0.f};
        cur = nxt; cA = nA; cB = nB; ++ui;
        if constexpr (ALIGN_EPI) { if (wr == 1) PG8_BAR; }
    }
    PG8_WAIT_V(0);
    if constexpr (!ALIGN_EPI) { if (wr == 0) PG8_BAR; }
    PG8_BAR;
    if constexpr (Epi::AFTER_DRAIN) { E.fused(acc, cur, wr, wc, fr, fq, lds, wid, lane); S.done(cur); }
#undef PG8_SA
#undef PG8_SB
#undef PG8_STAGE
#undef PG8_LDA
#undef PG8_LDB
#undef PG8_MMA
#undef PG8_WAIT_V
#undef PG8_WAIT_L
#undef PG8_BAR
#undef PG8_SCHED
}
}
namespace att {
#define LAS __attribute__((address_space(3)))
typedef unsigned short bf16_t;
typedef short bf16x8 __attribute__((ext_vector_type(8)));
typedef short s16x4 __attribute__((ext_vector_type(4)));
typedef float f32x4 __attribute__((ext_vector_type(4)));
typedef float f32x16 __attribute__((ext_vector_type(16)));
typedef unsigned u32x4 __attribute__((ext_vector_type(4)));
typedef unsigned u32x2 __attribute__((ext_vector_type(2)));
constexpr int PITCH = 6144;
constexpr int AOP = 2048;
constexpr int OFF_K = 0, OFF_V = 32768, OFF_KM = 65536, OFF_SLOT = 65536 + 8192;
constexpr float NEG = -1.0e30f;
__device__ __forceinline__ int toff(int row, int ch) { return 2048 * (row >> 3) + 512 * (ch >> 2) + 64 * (row & 7) + 16 * ((ch & 3) ^ ((row >> 2) & 3)); }
__device__ __forceinline__ float xsum32(float v) { auto rr = __builtin_amdgcn_permlane32_swap(__float_as_uint(v), __float_as_uint(v), false, false); return __uint_as_float(rr[0]) + __uint_as_float(rr[1]); }
__device__ __forceinline__ float xmax32(float v) { auto rr = __builtin_amdgcn_permlane32_swap(__float_as_uint(v), __float_as_uint(v), false, false); return fmaxf(__uint_as_float(rr[0]), __uint_as_float(rr[1])); }
__device__ __forceinline__ float bf2f(short x) { return __uint_as_float(((unsigned)(unsigned short)x) << 16); }
__device__ __forceinline__ s16x4 vtr(LAS const unsigned char* p) { typedef short v4i16_t __attribute__((ext_vector_type(4))); return __builtin_bit_cast(s16x4, __builtin_amdgcn_ds_read_tr16_b64_v4i16((LAS v4i16_t*)p)); }

struct TileSrc { int off; };
__device__ __forceinline__ TileSrc tile_src(int wid, int lane) {
    const int row = 8 * (wid >> 1) + ((lane & 31) >> 2);
    const int ch = 8 * (wid & 1) + 4 * (lane >> 5) + ((lane & 3) ^ ((row >> 2) & 3));
    TileSrc t; t.off = row * PITCH + 8 * ch; return t;
}
__device__ __forceinline__ void tile_dma(const TileSrc& ts, const bf16_t* Kg, const bf16_t* Vg, LAS unsigned char* kb, LAS unsigned char* vb, int wid) {
    __builtin_amdgcn_global_load_lds((const unsigned*)(Kg + ts.off), (LAS unsigned*)(kb + wid * 1024), 16, 0, 0);
    __builtin_amdgcn_global_load_lds((const unsigned*)(Kg + ts.off + 32 * PITCH), (LAS unsigned*)(kb + wid * 1024 + 8192), 16, 0, 0);
    __builtin_amdgcn_global_load_lds((const unsigned*)(Vg + ts.off), (LAS unsigned*)(vb + wid * 1024), 16, 0, 0);
    __builtin_amdgcn_global_load_lds((const unsigned*)(Vg + ts.off + 32 * PITCH), (LAS unsigned*)(vb + wid * 1024 + 8192), 16, 0, 0);
}

constexpr float THR = 8.0f;
#define MAX3(a, b, c) __builtin_fmaxf(__builtin_fmaxf((a), (b)), (c))
template <int NS, bool SEL>
__device__ __forceinline__ void tile_compute(f32x16 (&o)[4], f32x16& negm, float& mu, float& l, const bf16x8 (&qf)[NS], LAS const unsigned char* kb, LAS const unsigned char* vb,
                                             int kch0, int lane, bool causal, int qd, bool lane_sel, bool first) {
    const int l32 = lane & 31, hi = lane >> 5;
    const int kx = (l32 >> 2) & 3;
    LAS const unsigned char* kbase0 = kb + 2048 * (l32 >> 3) + 64 * (l32 & 7) + 512 * (kch0 >> 2) + 16 * (hi ^ kx);
    LAS const unsigned char* kbase1 = kb + 2048 * (l32 >> 3) + 64 * (l32 & 7) + 512 * (kch0 >> 2) + 16 * ((2 + hi) ^ kx);
    f32x16 st[2];
#pragma unroll
    for (int b = 0; b < 2; ++b) {
#pragma unroll
        for (int s = 0; s < NS; ++s) {
            const bf16x8 kf = *(LAS const bf16x8*)(((s & 1) ? kbase1 : kbase0) + 8192 * b + 512 * (s >> 1));
            st[b] = __builtin_amdgcn_mfma_f32_32x32x16_bf16(kf, qf[s], s == 0 ? negm : st[b], 0, 0, 0);
        }
        __builtin_amdgcn_sched_barrier(0);
    }
    if (causal) {
#pragma unroll
        for (int b = 0; b < 2; ++b)
#pragma unroll
            for (int r = 0; r < 16; ++r) { const int key = 32 * b + (r & 3) + 8 * (r >> 2) + 4 * hi; if (key > qd) st[b][r] = NEG; }
    }
    if (SEL) {
#pragma unroll
        for (int b = 0; b < 2; ++b)
#pragma unroll
            for (int r = 0; r < 16; ++r) st[b][r] = lane_sel ? st[b][r] : NEG;
    }
    float ra = MAX3(st[0][0], st[0][1], st[1][0]), rb = MAX3(st[0][2], st[0][3], st[1][1]);
    ra = MAX3(ra, st[1][2], st[1][3]);
#pragma unroll
    for (int r = 4; r < 16; r += 4) { ra = MAX3(ra, st[0][r], st[0][r + 1]); rb = MAX3(rb, st[0][r + 2], st[0][r + 3]); ra = MAX3(ra, st[1][r], st[1][r + 1]); rb = MAX3(rb, st[1][r + 2], st[1][r + 3]); }
    const float rm = xmax32(fmaxf(ra, rb));
    if (first || __any(rm > THR)) {
        const float dl = first ? rm : fmaxf(rm, 0.f);
        mu += dl;
#pragma unroll
        for (int b = 0; b < 2; ++b)
#pragma unroll
            for (int r = 0; r < 16; ++r) st[b][r] -= dl;
#pragma unroll
        for (int r = 0; r < 16; ++r) negm[r] = -mu;
        if (!first) { const float f = __builtin_amdgcn_exp2f(-dl); l *= f;
#pragma unroll
            for (int d = 0; d < 4; ++d) o[d] = o[d] * f; }
    }
    float sum = 0.f;
#pragma unroll
    for (int b = 0; b < 2; ++b)
#pragma unroll
        for (int r = 0; r < 16; ++r) { const float p = __builtin_amdgcn_exp2f(st[b][r]); st[b][r] = p; sum += p; }
    l += sum;
    bf16x8 pf[2][2];
#pragma unroll
    for (int b = 0; b < 2; ++b)
#pragma unroll
        for (int j = 0; j < 2; ++j) { u32x4 w; w.x = pg8::pk_bf16(st[b][8 * j + 0], st[b][8 * j + 1]); w.y = pg8::pk_bf16(st[b][8 * j + 2], st[b][8 * j + 3]);
            w.z = pg8::pk_bf16(st[b][8 * j + 4], st[b][8 * j + 5]); w.w = pg8::pk_bf16(st[b][8 * j + 6], st[b][8 * j + 7]); pf[b][j] = __builtin_bit_cast(bf16x8, w); }
    const int half = (lane >> 4) & 1, qp = (lane & 15) >> 2, p = lane & 3, c3 = 2 * half + (p >> 1);
    LAS const unsigned char* vbase0 = vb + 64 * (4 * hi + qp) + 16 * (c3 ^ hi) + 8 * (p & 1);
    LAS const unsigned char* vbase1 = vb + 64 * (4 * hi + qp) + 16 * (c3 ^ (2 + hi)) + 8 * (p & 1) + 2048;
#pragma unroll
    for (int d = 0; d < 4; ++d) {
        __builtin_amdgcn_sched_barrier(0);
#pragma unroll
        for (int b = 0; b < 2; ++b)
#pragma unroll
            for (int j = 0; j < 2; ++j) {
                const int co = 2048 * (4 * b + 2 * j) + 512 * d;
                const s16x4 lo = vtr(vbase0 + co), hh = vtr(vbase1 + co);
                const bf16x8 vf = {lo[0], lo[1], lo[2], lo[3], hh[0], hh[1], hh[2], hh[3]};
                o[d] = __builtin_amdgcn_mfma_f32_32x32x16_bf16(vf, pf[b][j], o[d], 0, 0, 0);
            }
    }
    __builtin_amdgcn_sched_barrier(0);
}

__device__ __forceinline__ void diff_unit(int b, int h, int i, const bf16_t* P, bf16_t* AO, float lam, const float* subln_g, LAS unsigned char* lds, int tid) {
    const int lane = tid & 63, wid = __builtin_amdgcn_readfirstlane(tid >> 6), w4 = wid >> 1, j = wid & 1, l32 = lane & 31, hi = lane >> 5;
    const size_t rowbase = (size_t)b * 4096; const int q0 = 128 * i + 32 * w4;
    bf16x8 qf[4];
    { const bf16_t* qp = P + (rowbase + q0 + l32) * PITCH + h * 128 + j * 64 + 8 * hi;
#pragma unroll
      for (int s = 0; s < 4; ++s) qf[s] = *(const bf16x8*)(qp + 16 * s); }
    const bf16_t* Kg = P + rowbase * PITCH + 1024 + h * 128; const bf16_t* Vg = P + rowbase * PITCH + 2048 + h * 128;
    f32x16 o[4];
#pragma unroll
    for (int d = 0; d < 4; ++d)
#pragma unroll
        for (int r = 0; r < 16; ++r) o[d][r] = 0.f;
    float mu = 0.f, l = 0.f; f32x16 negm;
#pragma unroll
    for (int r = 0; r < 16; ++r) negm[r] = 0.f;
    const int NT = 2 * (i + 1);
    const TileSrc ts = tile_src(wid, lane);
    tile_dma(ts, Kg, Vg, lds + OFF_K, lds + OFF_V, wid); __syncthreads();
    for (int t = 0; t < NT; ++t) {
        const int cur = t & 1;
        if (t + 1 < NT) tile_dma(ts, Kg + (size_t)(t + 1) * 64 * PITCH, Vg + (size_t)(t + 1) * 64 * PITCH, lds + OFF_K + (cur ^ 1) * 16384, lds + OFF_V + (cur ^ 1) * 16384, wid);
        const int key0 = 64 * t;
        if (key0 <= q0 + 31) tile_compute<4, false>(o, negm, mu, l, qf, lds + OFF_K + cur * 16384, lds + OFF_V + cur * 16384, 8 * j, lane, key0 + 63 > q0, q0 + l32 - key0, true, t == 0);
        __syncthreads();
    }
    const float inv = 1.0f / xsum32(l);
#pragma unroll
    for (int d = 0; d < 4; ++d) o[d] = o[d] * inv;
    LAS float* xb = (LAS float*)lds + w4 * 4096;
    if (j == 1) {
#pragma unroll
        for (int d = 0; d < 4; ++d)
#pragma unroll
            for (int r = 0; r < 16; ++r) xb[(d * 16 + r) * 64 + lane] = o[d][r];
    }
    __syncthreads();
    if (j == 0) {
        float ssq = 0.f;
#pragma unroll
        for (int d = 0; d < 4; ++d)
#pragma unroll
            for (int r = 0; r < 16; ++r) { const float v = o[d][r] - lam * xb[(d * 16 + r) * 64 + lane]; o[d][r] = v; ssq += v * v; }
        ssq = xsum32(ssq);
        const float rn = rsqrtf(ssq * (1.0f / 128.0f) + 1e-5f) * 0.8f;
        bf16_t* op = AO + (rowbase + q0 + l32) * AOP + h * 128 + 4 * hi;
#pragma unroll
        for (int d = 0; d < 4; ++d)
#pragma unroll
            for (int g = 0; g < 4; ++g) { const f32x4 gg = *(const f32x4*)(subln_g + 32 * d + 8 * g + 4 * hi);
                u32x2 w; w.x = pg8::pk_bf16(o[d][4 * g] * rn * gg[0], o[d][4 * g + 1] * rn * gg[1]); w.y = pg8::pk_bf16(o[d][4 * g + 2] * rn * gg[2], o[d][4 * g + 3] * rn * gg[3]);
                *(u32x2*)(op + 32 * d + 8 * g) = w; }
    }
    __syncthreads();
}

__device__ __forceinline__ void moba_unit(int b, int h, int blk, const bf16_t* P, bf16_t* AO, const float* kpart, LAS unsigned char* lds, int tid) {
    const int lane = tid & 63, wid = __builtin_amdgcn_readfirstlane(tid >> 6), l32 = lane & 31, hi = lane >> 5;
    const size_t rowbase = (size_t)b * 4096; const int q0 = 256 * blk + 32 * wid;
    bf16x8 qf[8];
    { const bf16_t* qp = P + (rowbase + q0 + l32) * PITCH + 3072 + h * 128 + 8 * hi;
#pragma unroll
      for (int s = 0; s < 8; ++s) qf[s] = *(const bf16x8*)(qp + 16 * s); }
    const bf16_t* Kg = P + rowbase * PITCH + 4096 + h * 128; const bf16_t* Vg = P + rowbase * PITCH + 5120 + h * 128;
    LAS float* km = (LAS float*)(lds + OFF_KM);
    for (int idx = tid; idx < blk * 128; idx += 512) { const int n = idx >> 7, d = idx & 127; const float* kp = kpart + (size_t)((b * 16 + n) * 2) * 1024 + h * 128 + d; km[idx] = kp[0] + kp[1024]; }
    const TileSrc ts = tile_src(wid, lane);
    tile_dma(ts, Kg + (size_t)(256 * blk) * PITCH, Vg + (size_t)(256 * blk) * PITCH, lds + OFF_K, lds + OFF_V, wid);
    __syncthreads();
    unsigned selmask = 0u;
    {
        float tv0 = -INFINITY, tv1 = -INFINITY, tv2 = -INFINITY; int ti0 = -1, ti1 = -1, ti2 = -1;
        for (int n = 0; n < blk; ++n) {
            float part = 0.f;
#pragma unroll
            for (int s = 0; s < 8; ++s) { const LAS float* kp = km + n * 128 + 16 * s + 8 * hi; const f32x4 ka = *(const LAS f32x4*)kp, kc = *(const LAS f32x4*)(kp + 4);
                part += bf2f(qf[s][0]) * ka[0] + bf2f(qf[s][1]) * ka[1] + bf2f(qf[s][2]) * ka[2] + bf2f(qf[s][3]) * ka[3] + bf2f(qf[s][4]) * kc[0] + bf2f(qf[s][5]) * kc[1] + bf2f(qf[s][6]) * kc[2] + bf2f(qf[s][7]) * kc[3]; }
            const float tot = xsum32(part);
            if (tot > tv0) { tv2 = tv1; ti2 = ti1; tv1 = tv0; ti1 = ti0; tv0 = tot; ti0 = n; }
            else if (tot > tv1) { tv2 = tv1; ti2 = ti1; tv1 = tot; ti1 = n; }
            else if (tot > tv2) { tv2 = tot; ti2 = n; }
        }
        if (ti0 >= 0) selmask |= 1u << ti0; if (ti1 >= 0) selmask |= 1u << ti1; if (ti2 >= 0) selmask |= 1u << ti2;
    }
    f32x16 o[4];
#pragma unroll
    for (int d = 0; d < 4; ++d)
#pragma unroll
        for (int r = 0; r < 16; ++r) o[d][r] = 0.f;
    float mu = 0.f, l = 0.f; f32x16 negm;
#pragma unroll
    for (int r = 0; r < 16; ++r) negm[r] = 0.f;
    const int NT = 4 + 4 * blk;
    for (int t = 0; t < NT; ++t) {
        const int cur = t & 1;
        if (t + 1 < NT) { const int t1 = t + 1; const int key0n = (t1 < 4) ? 256 * blk + 64 * t1 : 64 * (t1 - 4);
            tile_dma(ts, Kg + (size_t)key0n * PITCH, Vg + (size_t)key0n * PITCH, lds + OFF_K + (cur ^ 1) * 16384, lds + OFF_V + (cur ^ 1) * 16384, wid); }
        bool doit, causal, sel; int qd;
        if (t < 4) { const int kr = 64 * t, qr0 = 32 * wid; doit = kr <= qr0 + 31; causal = kr + 63 > qr0; qd = qr0 + l32 - kr; sel = true; }
        else { const int n = (t - 4) >> 2; sel = (selmask >> n) & 1u; doit = __any(sel); causal = false; qd = 0; }
        if (doit) tile_compute<8, true>(o, negm, mu, l, qf, lds + OFF_K + cur * 16384, lds + OFF_V + cur * 16384, 0, lane, causal, qd, sel, t == 0);
        __syncthreads();
    }
    const float inv = 1.0f / xsum32(l);
    bf16_t* op = AO + (rowbase + q0 + l32) * AOP + 1024 + h * 128 + 4 * hi;
#pragma unroll
    for (int d = 0; d < 4; ++d)
#pragma unroll
        for (int g = 0; g < 4; ++g) { u32x2 w; w.x = pg8::pk_bf16(o[d][4 * g] * inv, o[d][4 * g + 1] * inv); w.y = pg8::pk_bf16(o[d][4 * g + 2] * inv, o[d][4 * g + 3] * inv); *(u32x2*)(op + 32 * d + 8 * g) = w; }
}
}
#define LAS __attribute__((address_space(3)))
typedef unsigned short bf16;
typedef unsigned v4u __attribute__((ext_vector_type(4)));
typedef unsigned v2u __attribute__((ext_vector_type(2)));
typedef float f32x4 __attribute__((ext_vector_type(4)));
#ifndef REP_P0
#define REP_P0 1
#endif
#ifndef REP_P1
#define REP_P1 1
#endif
#ifndef REP_P3
#define REP_P3 1
#endif
#ifndef REP_P5
#define REP_P5 1
#endif
#ifndef ATT_REPS
#define ATT_REPS 1
#endif
#ifndef SKIPMASK
#define SKIPMASK 0
#endif
constexpr int NWAVES = 8;
constexpr int N_LAUNCHES = MK_N_LAUNCHES;
constexpr int NPH = 9;
constexpr int SEQ = 4096, NB = 4, M = NB * SEQ, D = 2048, NPROJ = 6144, FF = 5632, NUP = 2 * FF;
constexpr float LN_EPS = 1e-5f;
constexpr float ALPHA = 1.189207115002721f;
constexpr float LOG2E = 1.4426950408889634f;
constexpr size_t MiB = 1u << 20;
constexpr size_t WS_CTL = 0;
constexpr size_t WS_TABD = 1 * MiB, WS_TABM = WS_TABD + 4096 * 16 * 4;
constexpr size_t WS_KPART = 2 * MiB;
constexpr size_t WS_WUP = 4 * MiB, WS_WDOWN = 48 * MiB, WS_WIN = 72 * MiB, WS_WOUT = 96 * MiB;
constexpr size_t WS_XB = 104 * MiB, WS_P = 168 * MiB, WS_AO = 360 * MiB;
constexpr size_t WS_ACT = 168 * MiB;
constexpr size_t WS_HG = 424 * MiB, WS_FX = 428 * MiB;
constexpr size_t WS_H1B = 448 * MiB, WS_END = 512 * MiB;
static_assert(WS_ACT + (size_t)M * FF * 2 <= WS_AO && WS_FX + (size_t)64 * 4 * FF * 4 <= WS_H1B && WS_AO + (size_t)M * D * 2 <= WS_H1B && WS_WIN + (size_t)NPROJ * D * 2 <= WS_WOUT && WS_WDOWN + (size_t)D * FF * 2 <= WS_WIN, "ws map");
constexpr int LDS_BYTES = 147456;
constexpr int LDS_MISC = 131072;

struct Args { const float* in[16]; float* out; unsigned char* ws; float invD[8]; float invM[16]; int ph_lo, ph_hi; };

__device__ __forceinline__ float wave_sum(float v) {
#pragma unroll
    for (int o = 1; o < 64; o <<= 1) v += __shfl_xor(v, o);
    return v;
}
template <int UPMAP> __device__ __forceinline__ void p0_transpose_item(const float* W, int K, int N, bf16* WT, LAS float* scr, int item, int lane) {
    const int nblk = N / 32, kb = item / nblk, nb = item % nblk, k0 = 64 * kb, n0 = 32 * nb;
    const int r0 = UPMAP ? ((n0 < 5632) ? 256 * (n0 >> 7) + (n0 & 127) : 256 * ((n0 - 5632) >> 7) + 128 + ((n0 - 5632) & 127)) : n0;
#pragma unroll 8
    for (int i = 0; i < 32; ++i) { const int kk = 2 * i + (lane >> 5); scr[kk * 33 + (lane & 31)] = W[(size_t)(k0 + kk) * N + n0 + (lane & 31)]; }
    asm volatile("s_waitcnt lgkmcnt(0)" ::: "memory");
    const int c = lane & 7;
#pragma unroll
    for (int j = 0; j < 4; ++j) { const int n = (lane >> 3) + 8 * j; const LAS float* s = scr + (8 * c) * 33 + n;
        v4u o; o.x = pg8::pk_bf16(s[0 * 33], s[1 * 33]); o.y = pg8::pk_bf16(s[2 * 33], s[3 * 33]); o.z = pg8::pk_bf16(s[4 * 33], s[5 * 33]); o.w = pg8::pk_bf16(s[6 * 33], s[7 * 33]);
        *(v4u*)(WT + (size_t)(r0 + n) * K + k0 + 8 * c) = o; }
    asm volatile("s_waitcnt lgkmcnt(0)" ::: "memory");
}
__device__ __forceinline__ void ln_rows(float* io, bf16* ob, const float* g, const float* bta, int gw, int NGW, int lane) {
    for (int m = gw; m < M; m += NGW) {
        f32x4* xr = (f32x4*)(io + (size_t)m * D) + lane;
        f32x4 v[8]; float s = 0.f;
#pragma unroll
        for (int j = 0; j < 8; ++j) { v[j] = xr[64 * j]; s += (v[j].x + v[j].y) + (v[j].z + v[j].w); }
        const float mean = wave_sum(s) * (1.f / D); float s2 = 0.f;
#pragma unroll
        for (int j = 0; j < 8; ++j) { v[j] = v[j] - mean; s2 += (v[j].x * v[j].x + v[j].y * v[j].y) + (v[j].z * v[j].z + v[j].w * v[j].w); }
        const float rstd = rsqrtf(wave_sum(s2) * (1.f / D) + LN_EPS);
#pragma unroll
        for (int j = 0; j < 8; ++j) { const f32x4 gg = *((const f32x4*)g + lane + 64 * j), bb = *((const f32x4*)bta + lane + 64 * j);
            const f32x4 y = v[j] * rstd * gg + bb; xr[64 * j] = y;
            if (ob) { v2u w; w.x = pg8::pk_bf16(y.x, y.y); w.y = pg8::pk_bf16(y.z, y.w); *((v2u*)(ob + (size_t)m * D) + lane + 64 * j) = w; } }
    }
}

__global__ void __launch_bounds__(NWAVES * 64, 2) mega(Args args) {
    extern __shared__ __attribute__((aligned(16))) unsigned char lds_raw[];
    LAS unsigned char* lds = (LAS unsigned char*)lds_raw;
    cg::grid_group grid = cg::this_grid();
    const int G = gridDim.x, bx = blockIdx.x;
#define TIDS() int tid = threadIdx.x; asm volatile("" : "+v"(tid)); const int lane = tid & 63, wave = __builtin_amdgcn_readfirstlane(tid >> 6); const int gw = bx * NWAVES + wave, NGW = G * NWAVES; (void)lane; (void)gw; (void)NGW
    const int lo = args.ph_lo, hi = args.ph_hi;
#define IN(k) (lo <= (k) && (k) < hi)
#define SEAM(k) do { if (IN(k) && IN((k) + 1)) grid.sync(); } while (0)

    if (IN(0) && !(SKIPMASK & (1 << 0))) for (int rep_ = 0; rep_ < REP_P0; ++rep_) { if (rep_) grid.sync(); TIDS();
        const float* x = args.in[0]; const float* w_in = args.in[1]; const float* w_out = args.in[7]; const float* w_up = args.in[10]; const float* w_down = args.in[13]; unsigned char* ws = args.ws; unsigned* ctl = (unsigned*)(ws + WS_CTL); float* tabD = (float*)(ws + WS_TABD); float* tabM = (float*)(ws + WS_TABM); bf16* Wt_in = (bf16*)(ws + WS_WIN); bf16* Wt_out = (bf16*)(ws + WS_WOUT); bf16* Wt_up = (bf16*)(ws + WS_WUP); bf16* Wt_down = (bf16*)(ws + WS_WDOWN); bf16* XB = (bf16*)(ws + WS_XB);

        if (bx == 0 && tid == 0) { ctl[0] = 0u; ctl[64] = 0u; }
        LAS float* scr = (LAS float*)(lds + wave * 16384);
        constexpr int I_IN = (D / 64) * (NPROJ / 32), I_OUT = (D / 64) * (D / 32), I_UP = (D / 64) * (NUP / 32), I_DN = (FF / 64) * (D / 32);
        constexpr int NITEMS = I_IN + I_OUT + I_UP + I_DN;
        for (int it = gw; it < NITEMS; it += NGW) {
            int r = it;
            if (r < I_IN) { p0_transpose_item<0>(w_in, D, NPROJ, Wt_in, scr, r, lane); continue; } r -= I_IN;
            if (r < I_OUT) { p0_transpose_item<0>(w_out, D, D, Wt_out, scr, r, lane); continue; } r -= I_OUT;
            if (r < I_UP) { p0_transpose_item<1>(w_up, D, NUP, Wt_up, scr, r, lane); continue; } r -= I_UP;
            p0_transpose_item<0>(w_down, FF, D, Wt_down, scr, r, lane);
        }
        const int gt = bx * (NWAVES * 64) + tid, NGT = G * NWAVES * 64;
        for (size_t i = gt; i < (size_t)M * D / 8; i += NGT) { const f32x4 a = ((const f32x4*)x)[2 * i], b = ((const f32x4*)x)[2 * i + 1];
            v4u o; o.x = pg8::pk_bf16(a.x, a.y); o.y = pg8::pk_bf16(a.z, a.w); o.z = pg8::pk_bf16(b.x, b.y); o.w = pg8::pk_bf16(b.z, b.w); ((v4u*)XB)[i] = o; }
        for (int i = gt; i < SEQ * 24; i += NGT) { const int pos = i / 24, k = i % 24;
            if (k < 8) { const float ang = (float)pos * args.invD[k]; tabD[pos * 16 + k] = cosf(ang); tabD[pos * 16 + 8 + k] = sinf(ang); }
            else { const int kk = k - 8; const float ang = (float)pos * args.invM[kk]; tabM[pos * 32 + kk] = cosf(ang); tabM[pos * 32 + 16 + kk] = sinf(ang); } }
    }
    SEAM(0);
    if (IN(1) && !(SKIPMASK & (1 << 1))) for (int rep_ = 0; rep_ < REP_P1; ++rep_) { if (rep_) grid.sync(); TIDS();
        unsigned char* ws = args.ws; float* tabD = (float*)(ws + WS_TABD); float* tabM = (float*)(ws + WS_TABM); float* kpart = (float*)(ws + WS_KPART); bf16* Wt_in = (bf16*)(ws + WS_WIN); bf16* XB = (bf16*)(ws + WS_XB); bf16* P = (bf16*)(ws + WS_P);

        pg8::Gemm g{XB, Wt_in, M, NPROJ, D, D}; pg8::StaticOrder S; S.init(M, NPROJ, G, bx);
        pg8::EpiProj E{P, tabD, tabM, kpart, 0.125f * LOG2E, 0.08838834764831845f * LOG2E};
        pg8::gemm_phase<pg8::EpiProj, pg8::StaticOrder, true, true>(lds, g, S, E);
    }
    SEAM(1);
    if (IN(2) && !(SKIPMASK & (1 << 2))) { TIDS();
        const float* lq1 = args.in[2]; const float* lk1 = args.in[3]; const float* lq2 = args.in[4]; const float* lk2 = args.in[5]; const float* subln_g = args.in[6]; unsigned char* ws = args.ws; unsigned* ctl = (unsigned*)(ws + WS_CTL); float* kpart = (float*)(ws + WS_KPART); bf16* P = (bf16*)(ws + WS_P); bf16* AO = (bf16*)(ws + WS_AO);

        float lam;
        { const float a = wave_sum(lq1[lane] * lk1[lane]), b = wave_sum(lq2[lane] * lk2[lane]); lam = expf(a) - expf(b) + 0.2f; }
        volatile LAS int* slot = (volatile LAS int*)(lds + att::OFF_SLOT);
        for (int rep = 0; rep < ATT_REPS; ++rep)
        for (;;) {
            __syncthreads();
            if (tid == 0) *slot = (int)atomicAdd(ctl + 64 * rep, 1u);
            __syncthreads();
            const int idx = *slot;
            if (idx >= 1536) break;
            const int gq = 15 - idx / 96, rem = idx % 96, type = rem >> 5, bh = rem & 31, b = bh >> 3, h = bh & 7;
            if (type == 0) {
#ifndef NO_MOBA
 att::moba_unit(b, h, gq, P, AO, kpart, lds, tid);
#endif
 }
            else
#ifndef NO_DIFF
 att::diff_unit(b, h, type == 1 ? 2 * gq + 1 : 2 * gq, P, AO, lam, subln_g, lds, tid);
#else
 ;
#endif
        }
    }
    SEAM(2);
    if (IN(3) && !(SKIPMASK & (1 << 3))) for (int rep_ = 0; rep_ < REP_P3; ++rep_) { if (rep_) grid.sync(); TIDS();
        const float* x = args.in[0]; float* out = args.out; unsigned char* ws = args.ws; bf16* AO = (bf16*)(ws + WS_AO); bf16* Wt_out = (bf16*)(ws + WS_WOUT);

        pg8::Gemm g{AO, Wt_out, M, D, D, D}; pg8::StaticOrder S; S.init(M, D, G, bx);
        pg8::EpiResid E{x, out, D, ALPHA};
        pg8::gemm_phase<pg8::EpiResid, pg8::StaticOrder, true, true>(lds, g, S, E);
    }
    SEAM(3);
    if (IN(4) && !(SKIPMASK & (1 << 4))) { TIDS(); const float* ln1_g = args.in[8]; const float* ln1_b = args.in[9]; float* out = args.out; unsigned char* ws = args.ws; bf16* H1B = (bf16*)(ws + WS_H1B); ln_rows(out, H1B, ln1_g, ln1_b, gw, NGW, lane); }
    SEAM(4);
    if (IN(5) && !(SKIPMASK & (1 << 5))) for (int rep_ = 0; rep_ < REP_P5; ++rep_) { if (rep_) grid.sync(); TIDS();
        const float* conv_w = args.in[11]; const float* conv_b = args.in[12]; unsigned char* ws = args.ws;
        pg8::Gemm g{(bf16*)(ws + WS_H1B), (bf16*)(ws + WS_WUP), M, NUP, D, D}; pg8::StaticOrder S; S.init(M, NUP, G, bx);
        pg8::EpiConvGate E{(bf16*)(ws + WS_ACT), conv_w, conv_b, (float*)(ws + WS_HG), (float*)(ws + WS_FX), (LAS float*)(lds + LDS_MISC)};
        pg8::gemm_phase<pg8::EpiConvGate, pg8::StaticOrder, true, true>(lds, g, S, E);
    }
    SEAM(5);
    if (IN(7) && !(SKIPMASK & (1 << 7))) { TIDS();
        const float* conv_w = args.in[11]; float* out = args.out; unsigned char* ws = args.ws;
        bf16* ACT = (bf16*)(ws + WS_ACT); const float* HG = (const float*)(ws + WS_HG); const float* FX = (const float*)(ws + WS_FX);
        pg8::StaticOrder S; S.init(M, D, G, bx);
        { pg8::Unit u; int last = -1;
          for (int i = 0; S.next(i, u); ++i) { const int pm = u.pm; if ((pm & 15) == 0 || pm == last) continue; last = pm;
            for (int idx = tid; idx < 2 * (FF / 4); idx += NWAVES * 64) { const int r = idx / (FF / 4), f = 4 * (idx % (FF / 4));
                const f32x4 gp = *(const f32x4*)(FX + (((size_t)pm * 2 + r) * 2) * FF + f), vv = *(const f32x4*)(FX + (((size_t)pm * 2 + r) * 2 + 1) * FF + f);
                const f32x4 h1 = *(const f32x4*)(HG + ((size_t)(pm - 1) * 2 + 1) * FF + f), h2 = *(const f32x4*)(HG + ((size_t)(pm - 1) * 2) * FF + f);
                const f32x4 w0 = *(const f32x4*)(conv_w + f), w1 = *(const f32x4*)(conv_w + FF + f);
                const f32x4 gc = (r == 0) ? gp + w1 * h1 + w0 * h2 : gp + w0 * h1;
                f32x4 a;
#pragma unroll
                for (int e = 0; e < 4; ++e) a[e] = vv[e] * gc[e] * __builtin_amdgcn_rcpf(1.f + __builtin_amdgcn_exp2f(-1.4426950408889634f * gc[e]));
                v2u w; w.x = pg8::pk_bf16(a[0], a[1]); w.y = pg8::pk_bf16(a[2], a[3]);
                *(v2u*)(ACT + (size_t)(pm * 256 + r) * FF + f) = w; } }
          __threadfence(); __syncthreads(); }
        pg8::Gemm g{ACT, (bf16*)(ws + WS_WDOWN), M, D, FF, FF};
        pg8::EpiResid E{out, out, D, ALPHA};
        pg8::gemm_phase<pg8::EpiResid, pg8::StaticOrder, true, true>(lds, g, S, E);
    }
    SEAM(7);
    if (IN(8) && !(SKIPMASK & (1 << 8))) { TIDS(); const float* ln2_g = args.in[14]; const float* ln2_b = args.in[15]; float* out = args.out; ln_rows(out, nullptr, ln2_g, ln2_b, gw, NGW, lane); }
#undef IN
#undef SEAM
}

extern "C" void kernel_launch(void* const* d_in, const int* in_sizes, int n_in, void* d_out, int out_size, void* d_ws, size_t ws_size, hipStream_t stream) {
    static int grid = 0;
    if (grid == 0) {
        if (n_in != 16 || in_sizes[0] != M * D || out_size != M * D || ws_size < WS_END) { fprintf(stderr, "kernel_launch: unexpected shapes (n_in %d, in0 %d, out %d, ws %zu); nothing launched\n", n_in, n_in > 0 ? in_sizes[0] : -1, out_size, ws_size); grid = -1; return; }
        int dev = 0, cus = 0, per_cu = 0;
        if (hipGetDevice(&dev) != hipSuccess || hipDeviceGetAttribute(&cus, hipDeviceAttributeMultiprocessorCount, dev) != hipSuccess) { grid = -1; return; }
        if (hipFuncSetAttribute((const void*)mega, hipFuncAttributeMaxDynamicSharedMemorySize, LDS_BYTES) != hipSuccess) { fprintf(stderr, "kernel_launch: hipFuncSetAttribute failed\n"); grid = -1; return; }
        if (hipOccupancyMaxActiveBlocksPerMultiprocessor(&per_cu, (const void*)mega, NWAVES * 64, LDS_BYTES) != hipSuccess || per_cu < 1) { fprintf(stderr, "kernel_launch: occupancy query failed (%d)\n", per_cu); (void)hipGetLastError(); per_cu = 1; }
        grid = cus * per_cu;
    }
    if (grid < 0) return;
    Args a{};
    for (int i = 0; i < 16; ++i) a.in[i] = (const float*)d_in[i];
    a.out = (float*)d_out; a.ws = (unsigned char*)d_ws;
    for (int i = 0; i < 8; ++i) a.invD[i] = (float)(1.0 / pow(500000.0, (double)(2 * i) / 16.0));
    for (int i = 0; i < 16; ++i) a.invM[i] = (float)(1.0 / pow(500000.0, (double)(2 * i) / 32.0));
    if (N_LAUNCHES == 1) {
        a.ph_lo = 0; a.ph_hi = NPH;
        void* kargs[] = {&a};
        hipError_t e = hipLaunchCooperativeKernel((const void*)mega, dim3(grid), dim3(NWAVES * 64), kargs, LDS_BYTES, stream);
        if (e != hipSuccess) fprintf(stderr, "cooperative launch failed: %s (grid %d)\n", hipGetErrorString(e), grid);
    } else {
        for (int ph = 0; ph < NPH; ++ph) { a.ph_lo = ph; a.ph_hi = ph + 1; hipLaunchKernelGGL(mega, dim3(grid), dim3(NWAVES * 64), LDS_BYTES, stream, a); }
    }
}
```
